# Optimizing an MI355X kernel written in HIP

```python
import math
import jax, jax.numpy as jnp
from jax import lax
import numpy as np

D_MODEL = 1024
BATCH = 16
SEQ = 2048
DEPTH = 1

GRID_W = 64
CTX_LEN = 256
N_HEADS = 16
N_KV_HEADS = 4
HEAD_DIM = 64
KV_REP = N_HEADS // N_KV_HEADS
ATTN_W = N_HEADS * HEAD_DIM
KV_W = N_KV_HEADS * HEAD_DIM
Q_BLOCK = 128
ROPE_THETA = 10000.0
ROPE_AXIS_DIM = HEAD_DIM // 2
D_SSM = D_MODEL // 2
SSM_GROUP = 16
N_SSM_GROUPS = D_SSM // SSM_GROUP
SSM_STATE = 64
DT_MIN = 1e-3
DT_MAX = 1e-1
D_FF = 4 * D_MODEL
NORM_EPS = 1e-6
OFF_Q = 0
OFF_K = OFF_Q + ATTN_W
OFF_V = OFF_K + KV_W
OFF_U = OFF_V + KV_W
OFF_GA = OFF_U + D_SSM
OFF_GS = OFF_GA + D_MODEL
W_IN_COLS = OFF_GS + D_MODEL

kernel_name = 'hybrid_s5_gqa_gated_dit_block'


def rms_norm(x, g):
    xf = x.astype(jnp.float32)
    xf = xf * lax.rsqrt(jnp.mean(xf * xf, axis=-1, keepdims=True) + NORM_EPS)
    return xf.astype(x.dtype) * g


def modulate(h, shift, scale):
    return h * (1 + scale) + shift


def axial_rope_tables(n_tok):
    rows = n_tok // GRID_W
    row = jnp.repeat(jnp.arange(rows, dtype=jnp.float32), GRID_W)
    col = jnp.tile(jnp.arange(GRID_W, dtype=jnp.float32), rows)
    half = ROPE_AXIS_DIM // 2
    inv_freq = ROPE_THETA ** (-jnp.arange(half, dtype=jnp.float32) / half)
    ang = jnp.concatenate([row[:, None] * inv_freq, col[:, None] * inv_freq], axis=-1)
    return jnp.cos(ang), jnp.sin(ang)


def apply_axial_rope(x, cos, sin):
    xf = x.astype(jnp.float32)
    half = ROPE_AXIS_DIM // 2
    parts = []
    for axis_idx in range(2):
        xa = xf[..., axis_idx * ROPE_AXIS_DIM:(axis_idx + 1) * ROPE_AXIS_DIM]
        cs = cos[None, :, None, axis_idx * half:(axis_idx + 1) * half]
        sn = sin[None, :, None, axis_idx * half:(axis_idx + 1) * half]
        x1, x2 = xa[..., :half], xa[..., half:]
        parts += [x1 * cs - x2 * sn, x2 * cs + x1 * sn]
    return jnp.concatenate(parts, axis=-1).astype(x.dtype)


def attend(q, k, v):
    bsz, lq = q.shape[:2]
    nblk = lq // Q_BLOCK
    qb = q.reshape(bsz, nblk, Q_BLOCK, N_KV_HEADS, KV_REP, HEAD_DIM).transpose(1, 0, 2, 3, 4, 5)
    scale = HEAD_DIM ** -0.5

    def one_block(qblk):
        s = jnp.einsum('bqgrd,bkgd->bgrqk', qblk, k).astype(jnp.float32) * scale
        p = jax.nn.softmax(s, axis=-1).astype(v.dtype)
        return jnp.einsum('bgrqk,bkgd->bqgrd', p, v)

    o = lax.map(one_block, qb)
    return o.transpose(1, 0, 2, 3, 4, 5).reshape(bsz, lq, ATTN_W)


def ssm_discretize(lam_re, lam_im, log_dt, b_re, b_im):
    lam = lax.complex(lam_re.astype(jnp.float32), lam_im.astype(jnp.float32))
    dt = jnp.exp(log_dt.astype(jnp.float32))[:, None]
    a_bar = jnp.exp(lam * dt)
    b = lax.complex(b_re.astype(jnp.float32), b_im.astype(jnp.float32))
    b_bar = ((a_bar - 1) / lam)[..., None] * b
    return a_bar, b_bar


def _linear_recurrence_op(e1, e2):
    a1, b1 = e1
    a2, b2 = e2
    return a1 * a2, a2 * b1 + b2


def ssm_scan(u, a_bar, b_bar, h0, reverse):
    bsz, n = u.shape[:2]
    ug = u.astype(jnp.float32).reshape(bsz, n, N_SSM_GROUPS, SSM_GROUP).astype(jnp.complex64)
    bu = jnp.einsum('blgh,gph->blgp', ug, b_bar)
    edge = n - 1 if reverse else 0
    bu = bu.at[:, edge].add(a_bar * h0)
    a = jnp.broadcast_to(a_bar, bu.shape)
    _, states = lax.associative_scan(_linear_recurrence_op, (a, bu), reverse=reverse, axis=1)
    return states


def ssm_readout(states, c_re, c_im):
    bsz, n = states.shape[:2]
    cmat = lax.complex(c_re.astype(jnp.float32), c_im.astype(jnp.float32))
    y = jnp.einsum('blgp,ghp->blgh', states, cmat).real
    return y.reshape(bsz, n, D_SSM)


def merge_branches(attn_o, y_ssm, gate_a, gate_s, w_glu, b_glu, w_br_attn, w_br_ssm, w_out):
    y = jax.nn.gelu(y_ssm)
    y = y * jax.nn.sigmoid(y @ w_glu + b_glu)
    merged = jax.nn.sigmoid(gate_a) * (attn_o @ w_br_attn) + jax.nn.sigmoid(gate_s) * (y @ w_br_ssm)
    return merged @ w_out


def sq_relu_mlp(h, w1, b1, w2, b2):
    return jnp.square(jax.nn.relu(h @ w1 + b1)) @ w2 + b2


def _cols(p, base, start, stop):
    return p[..., start - base:stop - base]


def setup_inputs(seed: int = 0) -> dict:
    key = jax.random.key(seed)
    ks = jax.random.split(key, 32)
    nrm = lambda k, shape, s: jax.random.normal(k, shape, jnp.float32) * s
    G, P, H = N_SSM_GROUPS, SSM_STATE, SSM_GROUP
    lam_im_base = jnp.pi * jnp.arange(P, dtype=jnp.float32)
    return {
        'x': nrm(ks[0], (BATCH, SEQ, D_MODEL), 1.0),
        'c': nrm(ks[1], (BATCH, D_MODEL), 1.0),
        'ctx': nrm(ks[2], (BATCH, CTX_LEN, D_MODEL), 1.0),
        'c_ctx': nrm(ks[3], (D_MODEL,), 1.0),
        'w_mod': nrm(ks[4], (DEPTH, D_MODEL, 6 * D_MODEL), 0.5 * D_MODEL ** -0.5),
        'b_mod': nrm(ks[5], (DEPTH, 6 * D_MODEL), 0.01),
        'norm1_g': 1.0 + nrm(ks[6], (DEPTH, D_MODEL), 0.02),
        'norm2_g': 1.0 + nrm(ks[7], (DEPTH, D_MODEL), 0.02),
        'w_in': nrm(ks[8], (DEPTH, D_MODEL, W_IN_COLS), D_MODEL ** -0.5),
        'q_norm_g': 1.0 + nrm(ks[9], (DEPTH, HEAD_DIM), 0.02),
        'k_norm_g': 1.0 + nrm(ks[10], (DEPTH, HEAD_DIM), 0.02),
        'ssm_lambda_re': -0.5 + nrm(ks[11], (DEPTH, 2, G, P), 0.01),
        'ssm_lambda_im': lam_im_base + nrm(ks[12], (DEPTH, 2, G, P), 0.01),
        'ssm_log_dt': jax.random.uniform(ks[13], (DEPTH, 2, G), jnp.float32, math.log(DT_MIN), math.log(DT_MAX)),
        'ssm_b_re': nrm(ks[14], (DEPTH, 2, G, P, H), (2 * H) ** -0.5),
        'ssm_b_im': nrm(ks[15], (DEPTH, 2, G, P, H), (2 * H) ** -0.5),
        'ssm_c_re': nrm(ks[16], (DEPTH, 2, G, H, P), (2 * P) ** -0.5),
        'ssm_c_im': nrm(ks[17], (DEPTH, 2, G, H, P), (2 * P) ** -0.5),
        'ssm_d': nrm(ks[18], (DEPTH, D_SSM), 1.0),
        'w_glu': nrm(ks[19], (DEPTH, D_SSM, D_SSM), D_SSM ** -0.5),
        'b_glu': nrm(ks[20], (DEPTH, D_SSM), 0.01),
        'w_br_attn': nrm(ks[21], (DEPTH, ATTN_W, D_MODEL), ATTN_W ** -0.5),
        'w_br_ssm': nrm(ks[22], (DEPTH, D_SSM, D_MODEL), D_SSM ** -0.5),
        'w_out': nrm(ks[23], (DEPTH, D_MODEL, D_MODEL), D_MODEL ** -0.5),
        'w_mlp1': nrm(ks[24], (DEPTH, D_MODEL, D_FF), D_MODEL ** -0.5),
        'b_mlp1': nrm(ks[25], (DEPTH, D_FF), 0.01),
        'w_mlp2': nrm(ks[26], (DEPTH, D_FF, D_MODEL), D_FF ** -0.5),
        'b_mlp2': nrm(ks[27], (DEPTH, D_MODEL), 0.01),
    }


def reference(x, c, ctx, c_ctx, w_mod, b_mod, norm1_g, norm2_g, w_in, q_norm_g, k_norm_g,
              ssm_lambda_re, ssm_lambda_im, ssm_log_dt, ssm_b_re, ssm_b_im, ssm_c_re, ssm_c_im,
              ssm_d, w_glu, b_glu, w_br_attn, w_br_ssm, w_out, w_mlp1, b_mlp1, w_mlp2, b_mlp2):
    bsz, n_tok, _ = x.shape
    n_ctx = ctx.shape[1]
    cos, sin = axial_rope_tables(n_tok)
    h0_zero = jnp.zeros((bsz, N_SSM_GROUPS, SSM_STATE), jnp.complex64)
    ctx_s = ctx
    for l in range(DEPTH):
        last = l == DEPTH - 1
        sh1_l, sc1_l, g1_l, sh2_l, sc2_l, g2_l = jnp.split(
            (jax.nn.silu(c) @ w_mod[l] + b_mod[l])[:, None, :], 6, axis=-1)
        sh1_c, sc1_c, g1_c, sh2_c, sc2_c, g2_c = jnp.split(
            jax.nn.silu(c_ctx) @ w_mod[l] + b_mod[l], 6, axis=-1)

        h_l = modulate(rms_norm(x, norm1_g[l]), sh1_l, sc1_l)
        h_c = modulate(rms_norm(ctx_s, norm1_g[l]), sh1_c, sc1_c)
        p_l = h_l @ w_in[l]
        c0, c1 = (OFF_K, OFF_GA) if last else (0, W_IN_COLS)
        p_c = h_c @ w_in[l][:, c0:c1]

        q_l = apply_axial_rope(rms_norm(p_l[..., OFF_Q:OFF_K].reshape(bsz, n_tok, N_HEADS, HEAD_DIM), q_norm_g[l]), cos, sin)
        k_l = apply_axial_rope(rms_norm(p_l[..., OFF_K:OFF_V].reshape(bsz, n_tok, N_KV_HEADS, HEAD_DIM), k_norm_g[l]), cos, sin)
        v_l = p_l[..., OFF_V:OFF_U].reshape(bsz, n_tok, N_KV_HEADS, HEAD_DIM)
        u_l = p_l[..., OFF_U:OFF_GA]
        k_c = rms_norm(_cols(p_c, c0, OFF_K, OFF_V).reshape(bsz, n_ctx, N_KV_HEADS, HEAD_DIM), k_norm_g[l])
        v_c = _cols(p_c, c0, OFF_V, OFF_U).reshape(bsz, n_ctx, N_KV_HEADS, HEAD_DIM)
        u_c = _cols(p_c, c0, OFF_U, OFF_GA)

        attn_l = attend(q_l, jnp.concatenate([k_l, k_c], axis=1), jnp.concatenate([v_l, v_c], axis=1))

        a_f, b_f = ssm_discretize(ssm_lambda_re[l, 0], ssm_lambda_im[l, 0], ssm_log_dt[l, 0], ssm_b_re[l, 0], ssm_b_im[l, 0])
        a_b, b_b = ssm_discretize(ssm_lambda_re[l, 1], ssm_lambda_im[l, 1], ssm_log_dt[l, 1], ssm_b_re[l, 1], ssm_b_im[l, 1])
        s_cf = ssm_scan(u_c, a_f, b_f, h0_zero, reverse=False)
        s_cb = ssm_scan(u_c, a_b, b_b, h0_zero, reverse=True)
        y_l = (ssm_readout(ssm_scan(u_l, a_f, b_f, s_cf[:, -1], reverse=False), ssm_c_re[l, 0], ssm_c_im[l, 0])
               + ssm_readout(ssm_scan(u_l, a_b, b_b, s_cb[:, 0], reverse=True), ssm_c_re[l, 1], ssm_c_im[l, 1]))
        y_l = y_l.astype(x.dtype) + ssm_d[l] * u_l
        mix_l = merge_branches(attn_l, y_l, p_l[..., OFF_GA:OFF_GS], p_l[..., OFF_GS:W_IN_COLS],
                               w_glu[l], b_glu[l], w_br_attn[l], w_br_ssm[l], w_out[l])

        if not last:
            q_c = rms_norm(p_c[..., OFF_Q:OFF_K].reshape(bsz, n_ctx, N_HEADS, HEAD_DIM), q_norm_g[l])
            attn_c = attend(q_c, k_c, v_c)
            y_c = ssm_readout(s_cf, ssm_c_re[l, 0], ssm_c_im[l, 0]) + ssm_readout(s_cb, ssm_c_re[l, 1], ssm_c_im[l, 1])
            y_c = y_c.astype(ctx_s.dtype) + ssm_d[l] * u_c
            mix_c = merge_branches(attn_c, y_c, p_c[..., OFF_GA:OFF_GS], p_c[..., OFF_GS:W_IN_COLS],
                                   w_glu[l], b_glu[l], w_br_attn[l], w_br_ssm[l], w_out[l])
            ctx_s = ctx_s + g1_c * mix_c
            h2_c = modulate(rms_norm(ctx_s, norm2_g[l]), sh2_c, sc2_c)
            ctx_s = ctx_s + g2_c * sq_relu_mlp(h2_c, w_mlp1[l], b_mlp1[l], w_mlp2[l], b_mlp2[l])

        x = x + g1_l * mix_l
        h2_l = modulate(rms_norm(x, norm2_g[l]), sh2_l, sc2_l)
        x = x + g2_l * sq_relu_mlp(h2_l, w_mlp1[l], b_mlp1[l], w_mlp2[l], b_mlp2[l])
    return x
```

```cpp
#include <hip/hip_runtime.h>
#include <cstdio>
#include <cstdint>
#include <cmath>
namespace pg8 {
#define PG8_LAS __attribute__((address_space(3)))
typedef unsigned short bf16_t;
typedef short bf16x8 __attribute__((ext_vector_type(8)));
typedef float f32x4 __attribute__((ext_vector_type(4)));
typedef unsigned u32x4 __attribute__((ext_vector_type(4)));
constexpr int BM = 256, BK = 64, HALF = 128, HTB = HALF * BK * 2  , STAGE_BYTES = 8 * HTB, NXCD = 8, WGM = 8;

__host__ __device__ __forceinline__ int lds_byte(int r, int c) { const int st = (r >> 4) * 2 + (c >> 5), rr = r & 15, cc = c & 31, ob = rr * 64 + cc * 2; return st * 1024 + (ob ^ (((ob >> 9) & 1) << 5)); }
__host__ __device__ __forceinline__ void stage_rc(int b, int& R, int& C) { const int st = b / 1024, sb = b % 1024, swz = sb ^ (((sb >> 9) & 1) << 5); R = (st >> 1) * 16 + swz / 64; C = (st & 1) * 32 + (swz % 64) / 2; }
__host__ __device__ __forceinline__ int perm32(int rho) { const int n = rho >> 4, i = rho & 15; return 8 * (i >> 2) + 4 * n + (i & 3); }

struct Unit { int pm, pn; };
struct Gemm { const bf16_t* A; const bf16_t* Bt; int M, N, K, lda, ldb; };

struct StaticOrder {
    int nM, nN, nwg, G, c, wgm;
    __host__ __device__ void init(int M, int N, int G_, int c_, int wgm_ = WGM) { nM = M / BM; nN = N / BM; nwg = nM * nN; G = G_; c = c_; wgm = wgm_; }
    __host__ __device__ bool next(int i, Unit& u) const {
        const long L = (long)i * G + c; if (L >= nwg) return false;
        int wgid = (int)L; { const int q = nwg / NXCD, r = nwg % NXCD, xcd = wgid % NXCD, off = wgid / NXCD; wgid = (xcd < r ? xcd * (q + 1) : r * (q + 1) + (xcd - r) * q) + off; }
        const int nig = wgm * nN, gid = wgid / nig, fm = gid * wgm, gsz = (nM - fm) < wgm ? (nM - fm) : wgm;
        u.pm = fm + ((wgid % nig) % gsz); u.pn = (wgid % nig) / gsz; return true;
    }
    __device__ __forceinline__ void a_ready(const Unit&) const {}
    __device__ __forceinline__ void done(const Unit&) const {}
};

__device__ __forceinline__ unsigned cvt_pk_bf16(float lo, float hi) { unsigned r; asm volatile("v_cvt_pk_bf16_f32 %0, %1, %2" : "=v"(r) : "v"(lo), "v"(hi)); return r; }
typedef float f32x2 __attribute__((ext_vector_type(2)));
__device__ __forceinline__ f32x2 gelu_pk(f32x2 v) {
    const f32x2 av = __builtin_elementwise_abs(v), d = av * 0.2316418882f + 1.0f;
    f32x2 t; t.x = __builtin_amdgcn_rcpf(d.x); t.y = __builtin_amdgcn_rcpf(d.y);
    f32x2 q = t * 0.5307027145f + (-0.7265760135f); q = q * t + 0.7107068705f; q = q * t + (-0.142248368f); q = q * t + 0.127414796f; q = q * t;
    const f32x2 s = (v * v) * (-0.72134752044f);
    f32x2 e; e.x = __builtin_amdgcn_exp2f(s.x); e.y = __builtin_amdgcn_exp2f(s.y);
    const f32x2 m = v * (q * e), r = v - m;
    f32x2 o; o.x = v.x < 0.f ? m.x : r.x; o.y = v.y < 0.f ? m.y : r.y; return o;
}

template <int ACT  > struct EpiBf16 {
    static constexpr bool PERM = true, AFTER_DRAIN = false; static_assert(ACT == 0 || ACT == 1, "EpiBf16: ACT is 0 (none) or 1 (gelu_pk)");
    bf16_t* O; int ldc; const float* bias; int split_cols; size_t split_stride; float scale0;
    __device__ __forceinline__ void operator()(const f32x4 (&acc)[2][2][4][2], const Unit& u, int wr, int wc, int fr, int fq) const {
        const int row0 = u.pm * BM + wr * 64 + fr; int colt = u.pn * BM; bf16_t* base = O;
        float sc = 1.f; if (split_cols) { const int t = colt / split_cols; base += (size_t)t * split_stride; colt -= t * split_cols; if (t == 0) sc = scale0; }
        const int col0 = colt + wc * 32 + 8 * fq, bcol0 = u.pn * BM + wc * 32 + 8 * fq;
        f32x4 bv[2][2];
#pragma unroll
        for (int bj = 0; bj < 2; ++bj)
#pragma unroll
            for (int n = 0; n < 2; ++n) bv[bj][n] = bias ? *(const f32x4*)(bias + bcol0 + bj * HALF + 4 * n) : (f32x4){0.f, 0.f, 0.f, 0.f};
#pragma unroll
        for (int ai = 0; ai < 2; ++ai)
#pragma unroll
            for (int m = 0; m < 4; ++m) { bf16_t* rowp = base + (size_t)(row0 + ai * HALF + m * 16) * ldc + col0;
#pragma unroll
                for (int bj = 0; bj < 2; ++bj) { f32x4 v0 = acc[ai][bj][m][0] + bv[bj][0], v1 = acc[ai][bj][m][1] + bv[bj][1];
                    if (ACT == 1) { f32x2 a = gelu_pk((f32x2){v0[0], v0[1]}), b = gelu_pk((f32x2){v0[2], v0[3]}), c = gelu_pk((f32x2){v1[0], v1[1]}), d = gelu_pk((f32x2){v1[2], v1[3]});
                        v0 = (f32x4){a.x, a.y, b.x, b.y}; v1 = (f32x4){c.x, c.y, d.x, d.y}; }
                    v0 = v0 * sc; v1 = v1 * sc; u32x4 w; w.x = cvt_pk_bf16(v0[0], v0[1]); w.y = cvt_pk_bf16(v0[2], v0[3]); w.z = cvt_pk_bf16(v1[0], v1[1]); w.w = cvt_pk_bf16(v1[2], v1[3]);
                    *(u32x4*)(rowp + bj * HALF) = w; } }
    }
};
template <class Epi, class Sched, bool ALIGN_EPI = false, bool SP2 = false, int HOOKT = -1>
__device__ __forceinline__ void gemm_phase(PG8_LAS unsigned char* lds, const Gemm g, const Sched& S, const Epi& E) {
    const int tid = threadIdx.x, wid = __builtin_amdgcn_readfirstlane(tid >> 6), lane = tid & 63, wr = wid >> 2, wc = wid & 3, fr = lane & 15, fq = lane >> 4;
    const int K = g.K, nt = K / BK;
    unsigned voffA[2], voffB[2];
#pragma unroll
    for (int i = 0; i < 2; ++i) { int R, C; stage_rc(tid * 16 + i * 8192, R, C); const int Rb = Epi::PERM ? ((R & ~31) + perm32(R & 31)) : R;
        voffA[i] = (unsigned)(R * g.lda + C) * 2u; voffB[i] = (unsigned)(Rb * g.ldb + C) * 2u; }
    const size_t kstep = (size_t)(BK * 2);
    const size_t hstepA = (size_t)HALF * g.lda * 2, hstepB = (size_t)HALF * g.ldb * 2;
    const size_t tstepA = 2 * hstepA, tstepB = 2 * hstepB;
    const unsigned ldsw = (unsigned)wid * 1024u;
    const int aoff = lds_byte(wr * 64 + fr, fq * 8), boff = lds_byte(wc * 32 + fr, fq * 8);
#define PG8_SA(b, h) (((b) * 2 + (h)) * HTB)
#define PG8_SB(b, h) ((4 + (b) * 2 + (h)) * HTB)
#define PG8_STAGE(bufoff, gbase, voff) do { _Pragma("unroll") for (int _i = 0; _i < 2; ++_i) \
        __builtin_amdgcn_global_load_lds((const unsigned*)((const char*)(gbase) + (voff)[_i]), (PG8_LAS unsigned*)(lds + (bufoff) + ldsw + _i * 8192), 16, 0, 0); } while (0)
#define PG8_LDA(dst, b, h) do { _Pragma("unroll") for (int m = 0; m < 4; ++m) _Pragma("unroll") for (int k = 0; k < 2; ++k) dst[m][k] = *(const PG8_LAS bf16x8*)(lds + PG8_SA(b, h) + aoff + m * 2048 + k * 1024); } while (0)
#define PG8_LDB(dst, b, h) do { _Pragma("unroll") for (int n = 0; n < 2; ++n) _Pragma("unroll") for (int k = 0; k < 2; ++k) dst[n][k] = *(const PG8_LAS bf16x8*)(lds + PG8_SB(b, h) + boff + n * 2048 + k * 1024); } while (0)
#define PG8_MMA(ai, bj, At, Bt) do { __builtin_amdgcn_s_setprio(1); _Pragma("unroll") for (int m = 0; m < 4; ++m) _Pragma("unroll") for (int n = 0; n < 2; ++n) _Pragma("unroll") for (int k = 0; k < 2; ++k) \
        acc[ai][bj][m][n] = __builtin_amdgcn_mfma_f32_16x16x32_bf16(Bt[n][k], At[m][k], acc[ai][bj][m][n], 0, 0, 0); __builtin_amdgcn_s_setprio(0); } while (0)
#define PG8_WAIT_V(n) asm volatile("s_waitcnt vmcnt(" #n ")" ::: "memory")
#define PG8_WAIT_L(n) asm volatile("s_waitcnt lgkmcnt(" #n ")" ::: "memory")
#define PG8_BAR __builtin_amdgcn_s_barrier()
#define PG8_SCHED __builtin_amdgcn_sched_barrier(0)
    Unit cur, nxt; int ui = 0;
    if (!S.next(0, cur)) return;
    f32x4 acc[2][2][4][2];
#pragma unroll
    for (int a = 0; a < 2; ++a)
#pragma unroll
        for (int b = 0; b < 2; ++b)
#pragma unroll
            for (int m = 0; m < 4; ++m)
#pragma unroll
                for (int n = 0; n < 2; ++n) acc[a][b][m][n] = (f32x4){0.f, 0.f, 0.f, 0.f};
    bf16x8 At[4][2], B0[2][2], B1[2][2];
    const char* cA = (const char*)g.A + (size_t)cur.pm * tstepA; const char* cB = (const char*)g.Bt + (size_t)cur.pn * tstepB;
    S.a_ready(cur);
    if constexpr (SP2) {
        PG8_STAGE(PG8_SB(0, 0), cB, voffB); PG8_STAGE(PG8_SB(0, 1), cB + hstepB, voffB); PG8_STAGE(PG8_SA(0, 0), cA, voffA); PG8_STAGE(PG8_SA(0, 1), cA + hstepA, voffA);
        if (wr == 1) PG8_BAR;
        PG8_WAIT_V(2); PG8_BAR;
        PG8_STAGE(PG8_SB(1, 0), cB + kstep, voffB); PG8_STAGE(PG8_SA(1, 0), cA + kstep, voffA); PG8_STAGE(PG8_SB(1, 1), cB + hstepB + kstep, voffB);
        PG8_WAIT_V(6); PG8_BAR;
    } else {
        PG8_STAGE(PG8_SB(0, 0), cB, voffB); PG8_STAGE(PG8_SA(0, 0), cA, voffA); PG8_STAGE(PG8_SB(0, 1), cB + hstepB, voffB); PG8_STAGE(PG8_SA(0, 1), cA + hstepA, voffA);
        if (wr == 1) PG8_BAR;
        PG8_WAIT_V(4); PG8_BAR;
        PG8_STAGE(PG8_SB(1, 0), cB + kstep, voffB); PG8_STAGE(PG8_SA(1, 0), cA + kstep, voffA); PG8_STAGE(PG8_SB(1, 1), cB + hstepB + kstep, voffB);
        PG8_WAIT_V(6); PG8_BAR;
    }
    for (;;) {
        const bool has_next = S.next(ui + 1, nxt);
        const char* nA = has_next ? (const char*)g.A + (size_t)nxt.pm * tstepA : cA; const char* nB = has_next ? (const char*)g.Bt + (size_t)nxt.pn * tstepB : cB;
        for (int tseg = 0; tseg < nt; ) { const int tend = (HOOKT >= 0 && tseg < HOOKT) ? HOOKT : nt;
#pragma nounroll
        for (int t = tseg; t < tend; t += 2) {
            const bool last = (t == nt - 2);
            const char* a1 = cA + (size_t)(t + 1) * kstep;
            const char* a2 = last ? nA : cA + (size_t)(t + 2) * kstep; const char* b2 = last ? nB : cB + (size_t)(t + 2) * kstep;
            const char* a3 = a2 + kstep; const char* b3 = b2 + kstep;
            if (last && has_next) S.a_ready(nxt);
            if constexpr (SP2) {
            PG8_LDB(B0, 0, 0); PG8_LDB(B1, 0, 1); PG8_SCHED; PG8_LDA(At, 0, 0); PG8_STAGE(PG8_SA(1, 1), a1 + hstepA, voffA);
            PG8_WAIT_V(8); PG8_WAIT_L(0); PG8_BAR; PG8_MMA(0, 0, At, B0); PG8_MMA(0, 1, At, B1); PG8_BAR; PG8_SCHED;
            PG8_LDA(At, 0, 1); PG8_STAGE(PG8_SB(0, 0), b2, voffB); PG8_STAGE(PG8_SB(0, 1), b2 + hstepB, voffB); PG8_STAGE(PG8_SA(0, 0), a2, voffA);
            PG8_WAIT_V(8); PG8_WAIT_L(0); PG8_BAR; PG8_MMA(1, 0, At, B0); PG8_MMA(1, 1, At, B1); PG8_BAR; PG8_SCHED;
            PG8_LDB(B0, 1, 0); PG8_LDB(B1, 1, 1); PG8_SCHED; PG8_LDA(At, 1, 0); PG8_STAGE(PG8_SA(0, 1), a2 + hstepA, voffA);
            PG8_WAIT_V(8); PG8_WAIT_L(0); PG8_BAR; PG8_MMA(0, 0, At, B0); PG8_MMA(0, 1, At, B1); PG8_BAR; PG8_SCHED;
            PG8_LDA(At, 1, 1); PG8_STAGE(PG8_SB(1, 0), b3, voffB); PG8_STAGE(PG8_SB(1, 1), b3 + hstepB, voffB); PG8_STAGE(PG8_SA(1, 0), a3, voffA);
            PG8_WAIT_V(8); PG8_WAIT_L(0); PG8_BAR; PG8_MMA(1, 0, At, B0); PG8_MMA(1, 1, At, B1); PG8_BAR; PG8_SCHED;
            } else {
            PG8_LDB(B0, 0, 0); PG8_SCHED; PG8_LDA(At, 0, 0); PG8_STAGE(PG8_SA(1, 1), a1 + hstepA, voffA);
            PG8_WAIT_L(8); PG8_BAR; PG8_WAIT_L(0); PG8_MMA(0, 0, At, B0); PG8_BAR; PG8_SCHED;
            PG8_LDB(B1, 0, 1); PG8_STAGE(PG8_SB(0, 0), b2, voffB);
            PG8_BAR; PG8_WAIT_L(0); PG8_MMA(0, 1, At, B1); PG8_BAR;
            PG8_LDA(At, 0, 1); PG8_STAGE(PG8_SA(0, 0), a2, voffA);
            PG8_BAR; PG8_WAIT_L(0); PG8_MMA(1, 0, At, B0); PG8_BAR; PG8_SCHED;
            PG8_STAGE(PG8_SB(0, 1), b2 + hstepB, voffB);
            PG8_WAIT_V(6); PG8_BAR; PG8_MMA(1, 1, At, B1); PG8_BAR;
            PG8_LDB(B0, 1, 0); PG8_SCHED; PG8_LDA(At, 1, 0); PG8_STAGE(PG8_SA(0, 1), a2 + hstepA, voffA);
            PG8_WAIT_L(8); PG8_BAR; PG8_WAIT_L(0); PG8_MMA(0, 0, At, B0); PG8_BAR; PG8_SCHED;
            PG8_LDB(B1, 1, 1); PG8_STAGE(PG8_SB(1, 0), b3, voffB);
            PG8_BAR; PG8_WAIT_L(0); PG8_MMA(0, 1, At, B1); PG8_BAR;
            PG8_LDA(At, 1, 1); PG8_STAGE(PG8_SA(1, 0), a3, voffA);
            PG8_BAR; PG8_WAIT_L(0); PG8_MMA(1, 0, At, B0); PG8_BAR; PG8_SCHED;
            PG8_STAGE(PG8_SB(1, 1), b3 + hstepB, voffB);
            PG8_WAIT_V(6); PG8_BAR; PG8_MMA(1, 1, At, B1); PG8_BAR;
            }
        }
        if constexpr (HOOKT >= 0) { if (tend != nt) E.mid(acc, cur, wr, wc, fr, fq); }
        tseg = tend; }
        if constexpr (ALIGN_EPI) { if (wr == 0) PG8_BAR; }
        if constexpr (!Epi::AFTER_DRAIN) { E(acc, cur, wr, wc, fr, fq); S.done(cur); }
        if (!has_next) break;
#pragma unroll
        for (int a = 0; a < 2; ++a)
#pragma unroll
            for (int b = 0; b < 2; ++b)
#pragma unroll
                for (int m = 0; m < 4; ++m)
#pragma unroll
                    for (int n = 0; n < 2; ++n) acc[a][b][m][n] = (f32x4){0.f, 0.f, 0.f, 0.f};
        cur = nxt; cA = nA; cB = nB; ++ui;
        if constexpr (ALIGN_EPI) { if (wr == 1) PG8_BAR; }
    }
    PG8_WAIT_V(0);
    if constexpr (!ALIGN_EPI) { if (wr == 0) PG8_BAR; }
    PG8_BAR;
    if constexpr (Epi::AFTER_DRAIN) { E.fused(acc, cur, wr, wc, fr, fq, lds, wid, lane); S.done(cur); }
#undef PG8_SA
#undef PG8_SB
#undef PG8_STAGE
#undef PG8_LDA
#undef PG8_LDB
#undef PG8_MMA
#undef PG8_WAIT_V
#undef PG8_WAIT_L
#undef PG8_BAR
#undef PG8_SCHED
}
}
#include <hip/hip_bf16.h>
#include <cmath>
namespace attn_body {
using bf16=__hip_bfloat16;
using bf16x8=__attribute__((ext_vector_type(8)))short;
using s16x4=__attribute__((ext_vector_type(4)))short;
using f32x16=__attribute__((ext_vector_type(16)))float;
using u32x4=__attribute__((ext_vector_type(4)))unsigned;
constexpr int NHEAD=16,SEQ=2048,D=64;
constexpr int NKT=36, NKT_LAT=32;
constexpr int NW=8,QBLK=32,QB=QBLK*NW,KVBLK=64,NQB=SEQ/QB;
constexpr int ATTN_UNIT_ROWS=QB;
__device__ __forceinline__ int crow(int r,int hi){return (r&3)+8*(r>>2)+4*hi;}
#define SBAR() __builtin_amdgcn_sched_barrier(0)
__device__ __forceinline__ void cmask(f32x16&p0,f32x16&p1,int jb,int qrel,int hi){
  const float NEG=-INFINITY; int kb=64*jb+4*hi;
  #pragma unroll
  for(int r=0;r<16;++r){int kv=kb+(r&3)+8*(r>>2); if(kv>qrel)p0[r]=NEG; if(kv+32>qrel)p1[r]=NEG;}
}

constexpr int NSLOT=3, SLOTB=8192;
constexpr int LDS_K=0, LDS_V=NSLOT*SLOTB, LDS_WS=2*NSLOT*SLOTB, LDS_OST=LDS_WS+NW*64*4, LDS_BYTES=LDS_OST+NW*4096;
constexpr float C2=0.125f*1.4426950408889634f;
__device__ __forceinline__ void glds16(const void*gsrc,unsigned lds_dst){unsigned keep;
  asm volatile("s_mov_b32 %0, m0\n\ts_mov_b32 m0, %2\n\ts_nop 0\n\tglobal_load_lds_dwordx4 %1, off\n\ts_mov_b32 m0, %0":"=&s"(keep):"v"(gsrc),"s"(lds_dst):"memory");}
__device__ __forceinline__ float max3f(float a,float b,float c){float r;asm("v_max3_f32 %0, %1, %2, %3":"=v"(r):"v"(a),"v"(b),"v"(c));return r;}
__device__ __forceinline__ float max2f(float a,float b){float r;asm("v_max_f32_e32 %0, %1, %2":"=v"(r):"v"(a),"v"(b));return r;}
__device__ __forceinline__ float fadd_s(float a,float b){float r;asm("v_add_f32_e32 %0, %1, %2":"=v"(r):"v"(a),"v"(b));return r;}
__device__ __forceinline__ float fsub_s(float a,float b){float r;asm("v_sub_f32_e32 %0, %1, %2":"=v"(r):"v"(a),"v"(b));return r;}
typedef float f32x2_t __attribute__((ext_vector_type(2))); typedef __bf16 bf16x2_t __attribute__((ext_vector_type(2)));
__device__ __forceinline__ unsigned cvtpk_s(float lo,float hi){f32x2_t v={lo,hi};bf16x2_t b=__builtin_convertvector(v,bf16x2_t);return __builtin_bit_cast(unsigned,b);}
#define WAIT_BAR(N) asm volatile("s_waitcnt vmcnt(" #N ") lgkmcnt(0)\n\ts_barrier":::"memory")

__device__ __forceinline__ void qkt(f32x16&p0,f32x16&p1,const char*Kslot,const bf16x8*qr,const f32x16&negm,int r32,int hi){
  const char*kb=Kslot+hi*1024+r32*16;
  #pragma unroll
  for(int d0=0;d0<4;++d0){
    const bf16x8 b0=*reinterpret_cast<const bf16x8*>(kb+d0*2048);
    const bf16x8 b1=*reinterpret_cast<const bf16x8*>(kb+d0*2048+512);
    if(d0==0){p0=__builtin_amdgcn_mfma_f32_32x32x16_bf16(b0,qr[0],negm,0,0,0);p1=__builtin_amdgcn_mfma_f32_32x32x16_bf16(b1,qr[0],negm,0,0,0);}
    else{p0=__builtin_amdgcn_mfma_f32_32x32x16_bf16(b0,qr[d0],p0,0,0,0);p1=__builtin_amdgcn_mfma_f32_32x32x16_bf16(b1,qr[d0],p1,0,0,0);}}
}
typedef __attribute__((address_space(3))) const char* lds_cptr;
typedef short v4i16_t __attribute__((ext_vector_type(4)));
__device__ __forceinline__ void kload8(bf16x8*kf,lds_cptr kp){
  kf[0]=*(const __attribute__((address_space(3))) bf16x8*)(kp);      kf[1]=*(const __attribute__((address_space(3))) bf16x8*)(kp+512);
  kf[2]=*(const __attribute__((address_space(3))) bf16x8*)(kp+2048); kf[3]=*(const __attribute__((address_space(3))) bf16x8*)(kp+2560);
  kf[4]=*(const __attribute__((address_space(3))) bf16x8*)(kp+4096); kf[5]=*(const __attribute__((address_space(3))) bf16x8*)(kp+4608);
  kf[6]=*(const __attribute__((address_space(3))) bf16x8*)(kp+6144); kf[7]=*(const __attribute__((address_space(3))) bf16x8*)(kp+6656);
}
__device__ __forceinline__ void kload2(bf16x8*kf,lds_cptr kp,int j){ kf[2*j]=*(const __attribute__((address_space(3))) bf16x8*)(kp+j*2048); kf[2*j+1]=*(const __attribute__((address_space(3))) bf16x8*)(kp+j*2048+512); }
__device__ __forceinline__ s16x4 vtr(lds_cptr p){ return __builtin_bit_cast(s16x4,__builtin_amdgcn_ds_read_tr16_b64_v4i16((__attribute__((address_space(3))) v4i16_t*)p)); }
__device__ __forceinline__ float rowmax(const f32x16&p0,const f32x16&p1){
  float a=max3f(p0[0],p0[1],p1[0]),b=max3f(p0[2],p0[3],p1[1]);a=max3f(a,p1[2],p1[3]);
  #pragma unroll
  for(int r=4;r<16;r+=4){a=max3f(a,p0[r],p0[r+1]);b=max3f(b,p0[r+2],p0[r+3]);a=max3f(a,p1[r],p1[r+1]);b=max3f(b,p1[r+2],p1[r+3]);}
  const float m=max2f(a,b);
  auto rr=__builtin_amdgcn_permlane32_swap(__float_as_uint(m),__float_as_uint(m),false,false);
  return max2f(__uint_as_float(rr[0]),__uint_as_float(rr[1]));
}
__device__ __forceinline__ void pv(f32x16*o,int vb,bf16x8 pa0,bf16x8 pa1,bf16x8 pa2,bf16x8 pa3){
  #pragma unroll
  for(int d0=0;d0<2;++d0){s16x4 lo[4],hi[4];
    #pragma unroll
    for(int ks=0;ks<4;++ks){
      asm volatile("ds_read_b64_tr_b16 %0,%1 offset:%c2":"=&v"(lo[ks]):"v"(vb),"i"(d0*4096+ks*1024):"memory");
      asm volatile("ds_read_b64_tr_b16 %0,%1 offset:%c2":"=&v"(hi[ks]):"v"(vb),"i"(d0*4096+ks*1024+512):"memory");}
    asm volatile("s_waitcnt lgkmcnt(0)":::"memory");SBAR();
    #define PK(k) (bf16x8){lo[k][0],lo[k][1],lo[k][2],lo[k][3],hi[k][0],hi[k][1],hi[k][2],hi[k][3]}
    o[d0]=__builtin_amdgcn_mfma_f32_32x32x16_bf16(pa0,PK(0),o[d0],0,0,0);
    o[d0]=__builtin_amdgcn_mfma_f32_32x32x16_bf16(pa1,PK(1),o[d0],0,0,0);
    o[d0]=__builtin_amdgcn_mfma_f32_32x32x16_bf16(pa2,PK(2),o[d0],0,0,0);
    o[d0]=__builtin_amdgcn_mfma_f32_32x32x16_bf16(pa3,PK(3),o[d0],0,0,0);
    #undef PK
  }
}

#ifndef ATTN_STORE16
#define ATTN_STORE16(p,v) (*(u32x4*)(p)=(v))
#endif
template<int THRL,int QP,int KVP,int OP> __device__ __forceinline__ void attn_unit(int h,int qb,const bf16*Qb,const bf16*Kl,const bf16*Vl,const bf16*Kc,const bf16*Vc,bf16*Ob,char*shm){
  int tid=threadIdx.x; asm volatile("":"+v"(tid));
  const int lane=tid&63,r32=lane&31,hi=lane>>5; const int wid=__builtin_amdgcn_readfirstlane(tid>>6);
  const int q0=qb*QB;
  const bf16*Qw=Qb+(long)(q0+wid*QBLK)*QP+h*D;
  const int kvh=h>>2; const bf16*Kh=Kl+kvh*D,*Vh=Vl+kvh*D; const long cdk=(Kc-Kl)-(long)NKT_LAT*KVBLK*KVP, cdv=(Vc-Vl)-(long)NKT_LAT*KVBLK*KVP;
  const unsigned lds0=(unsigned)(uintptr_t)shm;
  float*wsf=(float*)(shm+LDS_WS)+wid*64;
  const bf16*ksrc=Kh+(long)lane*KVP+wid*8;
  const bf16*vsrc=Vh+(long)(16*(wid&3)+(lane>>2))*KVP+(wid>>2)*32+(lane&3)*8;
  const unsigned kdst=lds0+LDS_K+wid*1024, vdst=lds0+LDS_V+wid*1024;
  #define DMA_K(t,slot) glds16(ksrc+(long)(t)*KVBLK*KVP+(((t)>=NKT_LAT)?cdk:0l),(unsigned)__builtin_amdgcn_readfirstlane(kdst+(slot)))
  #define DMA_V(t,slot) glds16(vsrc+(long)(t)*KVBLK*KVP+(((t)>=NKT_LAT)?cdv:0l),(unsigned)__builtin_amdgcn_readfirstlane(vdst+(slot)))
  const int vb0=(int)(lds0+LDS_V)+((lane>>4)&1)*32+(lane&3)*8+(4*hi+((lane&15)>>2))*64;
  const char*Kbase=shm+LDS_K; bf16x8 kf[8];
  const lds_cptr shm3=(lds_cptr)shm; const lds_cptr kp0=shm3+LDS_K+hi*1024+r32*16; const lds_cptr vp0=shm3+LDS_V+((lane>>4)&1)*32+(lane&3)*8+(4*hi+((lane&15)>>2))*64;
  constexpr int NT=NKT;
  DMA_K(0,0);DMA_V(0,0);DMA_K(1,SLOTB);
  bf16x8 qr[4];
  #pragma unroll
  for(int d0=0;d0<4;++d0)qr[d0]=*reinterpret_cast<const bf16x8*>(&Qw[(long)r32*QP+d0*16+hi*8]);
  float mhat=0.f,l_reg=0.f;f32x16 o[2];o[0]=f32x16{};o[1]=f32x16{};f32x16 negm=f32x16{};asm volatile("":"+v"(negm));
  #define CMASK(P0,P1,t) do{}while(0)
  bool resc=false;
  #define START(P0,P1) do{ const float rm=rowmax(P0,P1); resc=false; \
    { const float dl=rm; mhat=fadd_s(mhat,dl); \
      _Pragma("unroll") for(int r=0;r<16;++r){P0[r]=fsub_s(P0[r],dl);P1[r]=fsub_s(P1[r],dl);} \
      _Pragma("unroll") for(int r=0;r<16;++r)negm[r]=-mhat; asm volatile("":"+v"(negm)); } \
    _Pragma("unroll") for(int r=0;r<16;++r)P0[r]=__builtin_amdgcn_exp2f(P0[r]); }while(0)
  #define RESC() do{ if(resc){ asm volatile("s_waitcnt lgkmcnt(0)":::"memory"); \
      _Pragma("unroll") for(int d_=0;d_<2;++d_) _Pragma("unroll") for(int r=0;r<16;++r)o[d_][r]*=wsf[crow(r,hi)]; } }while(0)
  f32x16 pA0,pA1,pB0,pB1;
  int sl_prev=0,sl_cur=0,sl_next=SLOTB;
  #define ROT() do{sl_prev=sl_cur;sl_cur=sl_next;sl_next=(sl_next==(NSLOT-1)*SLOTB)?0:sl_next+SLOTB;}while(0)
  DMA_K(2,2*SLOTB);
  WAIT_BAR(3);
  qkt(pA0,pA1,Kbase,qr,negm,r32,hi);asm volatile("s_nop 15\n\ts_nop 7":"+v"(pA0),"+v"(pA1));CMASK(pA0,pA1,0);
  START(pA0,pA1);
  _Pragma("unroll") for(int r=0;r<16;++r)pA1[r]=__builtin_amdgcn_exp2f(pA1[r]);
  WAIT_BAR(0);
  DMA_K(3,0);DMA_V(1,SLOTB);
  ROT();
  kload8(kf,kp0+sl_cur);
  WAIT_BAR(2);
  s16x4 vlo[8],vhi[8]; u32x4 pw0,pw1,pw2,pw3;
  #define PKW(P,B) cvtpk_s(P[B],P[B+1])
  #define PAF(k) __builtin_bit_cast(bf16x8,pw##k)
  #define VFR(i) (bf16x8){vlo[i][0],vlo[i][1],vlo[i][2],vlo[i][3],vhi[i][0],vhi[i][1],vhi[i][2],vhi[i][3]}
  #define PIN(x) asm volatile("":"+v"(x))
  #define MX3(a,b,c) __builtin_fmaxf(__builtin_fmaxf((a),(b)),(c))
  #define GAPA(MF,A0,A1,A2,A3,W0,W1,PW) do{ MF; sacc+=A0; sacc+=A1; sacc+=A2; sacc+=A3; PIN(sacc); W0; W1; PIN(PW); SBAR(); }while(0)
  #define EX(v) __builtin_amdgcn_exp2f(v)
  #define GAPB(MF,X,B) do{ MF; X[B]=EX(X[B]); X[B+1]=EX(X[B+1]); X[B+2]=EX(X[B+2]); X[B+3]=EX(X[B+3]); PIN(X); SBAR(); }while(0)
  #define VRD(i) do{ vlo[i]=vtr(vp_+(((i)>>2)*4096+((i)&3)*1024)); vhi[i]=vtr(vp_+(((i)>>2)*4096+((i)&3)*1024+512)); }while(0)
  #define KRD(G,j) do{ if(G){ kload2(kf,kp0+sl_next,j); SBAR(); } }while(0)
  #define STEP(C0,C1,P0,P1,t,GK,GV,GL) do{ SBAR(); \
    const lds_cptr vp_=vp0+sl_prev; \
    VRD(0); SBAR(); float sacc=(P0[0]+P0[1]); \
    GAPA(C0=__builtin_amdgcn_mfma_f32_32x32x16_bf16(kf[0],qr[0],negm,0,0,0), P0[2],P0[3],P0[4],P0[5],     pw0[0]=PKW(P0,0), pw0[1]=PKW(P0,2), pw0); \
    VRD(4); SBAR(); GAPA(C1=__builtin_amdgcn_mfma_f32_32x32x16_bf16(kf[1],qr[0],negm,0,0,0), P0[6],P0[7],P0[8],P0[9],     pw0[2]=PKW(P0,4), pw0[3]=PKW(P0,6), pw0); \
    VRD(1); SBAR(); GAPA(C0=__builtin_amdgcn_mfma_f32_32x32x16_bf16(kf[2],qr[1],C0,0,0,0),   P0[10],P0[11],P0[12],P0[13], pw1[0]=PKW(P0,8), pw1[1]=PKW(P0,10), pw1); \
    VRD(5); SBAR(); GAPA(C1=__builtin_amdgcn_mfma_f32_32x32x16_bf16(kf[3],qr[1],C1,0,0,0),   P0[14],P0[15],P1[0],P1[1],   pw1[2]=PKW(P0,12),pw1[3]=PKW(P0,14), pw1); \
    VRD(2); SBAR(); GAPA(C0=__builtin_amdgcn_mfma_f32_32x32x16_bf16(kf[4],qr[2],C0,0,0,0),   P1[2],P1[3],P1[4],P1[5],     pw2[0]=PKW(P1,0), pw2[1]=PKW(P1,2), pw2); \
    VRD(6); SBAR(); GAPA(C1=__builtin_amdgcn_mfma_f32_32x32x16_bf16(kf[5],qr[2],C1,0,0,0),   P1[6],P1[7],P1[8],P1[9],     pw2[2]=PKW(P1,4), pw2[3]=PKW(P1,6), pw2); \
    VRD(3); SBAR(); GAPA(C0=__builtin_amdgcn_mfma_f32_32x32x16_bf16(kf[6],qr[3],C0,0,0,0),   P1[10],P1[11],P1[12],P1[13], pw3[0]=PKW(P1,8), pw3[1]=PKW(P1,10), pw3); \
    VRD(7); SBAR(); GAPA(C1=__builtin_amdgcn_mfma_f32_32x32x16_bf16(kf[7],qr[3],C1,0,0,0),   P1[14],P1[15],0.f,0.f,       pw3[2]=PKW(P1,12),pw3[3]=PKW(P1,14), pw3); \
    l_reg+=sacc; \
    if(GK){DMA_K((t)+3,sl_cur);} if(GV){DMA_V((t)+1,sl_next);} \
    CMASK(C0,C1,t); \
    { float a=MX3(C0[0],C0[1],C1[0]),b=MX3(C0[2],C0[3],C1[1]); a=MX3(a,C1[2],C1[3]); \
      _Pragma("unroll") for(int r=4;r<16;r+=4){a=MX3(a,C0[r],C0[r+1]);b=MX3(b,C0[r+2],C0[r+3]);a=MX3(a,C1[r],C1[r+1]);b=MX3(b,C1[r+2],C1[r+3]);} \
      float rm=__builtin_fmaxf(a,b); { auto rr=__builtin_amdgcn_permlane32_swap(__float_as_uint(rm),__float_as_uint(rm),false,false); rm=__builtin_fmaxf(__uint_as_float(rr[0]),__uint_as_float(rr[1])); } \
      resc=false; \
      if(__builtin_expect(__any(rm>(float)THRL),0)){ const float dl=__builtin_fmaxf(rm,0.f); mhat+=dl; \
        _Pragma("unroll") for(int r=0;r<16;++r){C0[r]-=dl;C1[r]-=dl;} \
        _Pragma("unroll") for(int r=0;r<16;++r)negm[r]=-mhat; asm volatile("":"+v"(negm)); \
        const float f=__builtin_amdgcn_exp2f(-dl); l_reg*=f; if(hi==0)wsf[r32]=f; resc=true; } } \
    SBAR(); \
    GAPB(o[0]=__builtin_amdgcn_mfma_f32_32x32x16_bf16(PAF(0),VFR(0),o[0],0,0,0), C0,0); \
    GAPB(o[1]=__builtin_amdgcn_mfma_f32_32x32x16_bf16(PAF(0),VFR(4),o[1],0,0,0), C0,4); \
    KRD(GL,0); GAPB(o[0]=__builtin_amdgcn_mfma_f32_32x32x16_bf16(PAF(1),VFR(1),o[0],0,0,0), C0,8); \
    KRD(GL,1); GAPB(o[1]=__builtin_amdgcn_mfma_f32_32x32x16_bf16(PAF(1),VFR(5),o[1],0,0,0), C0,12); \
    KRD(GL,2); GAPB(o[0]=__builtin_amdgcn_mfma_f32_32x32x16_bf16(PAF(2),VFR(2),o[0],0,0,0), C1,0); \
    KRD(GL,3); GAPB(o[1]=__builtin_amdgcn_mfma_f32_32x32x16_bf16(PAF(2),VFR(6),o[1],0,0,0), C1,4); \
    GAPB(o[0]=__builtin_amdgcn_mfma_f32_32x32x16_bf16(PAF(3),VFR(3),o[0],0,0,0), C1,8); \
    GAPB(o[1]=__builtin_amdgcn_mfma_f32_32x32x16_bf16(PAF(3),VFR(7),o[1],0,0,0), C1,12); \
    }while(0)
  int t=1;
  #undef CMASK
  #define CMASK(P0,P1,t) do{}while(0)
  for(;t+5<NT;t+=2){
    STEP(pB0,pB1,pA0,pA1,t,true,true,true);     WAIT_BAR(2); RESC(); ROT();
    STEP(pA0,pA1,pB0,pB1,t+1,true,true,true);   WAIT_BAR(2); RESC(); ROT();
  }
  #undef CMASK
  #define CMASK(P0,P1,t) do{}while(0)
  #define ENDW(tt) do{ if((tt)+3<NT){WAIT_BAR(2);} else if((tt)+2<NT){WAIT_BAR(1);} else {WAIT_BAR(0);} }while(0)
  for(;t+1<NT;t+=2){
    STEP(pB0,pB1,pA0,pA1,t,(t+3<NT),(t+1<NT),(t+1<NT));       ENDW(t);   RESC(); ROT();
    STEP(pA0,pA1,pB0,pB1,t+1,(t+4<NT),(t+2<NT),(t+2<NT));     ENDW(t+1); RESC(); ROT();
  }
  STEP(pB0,pB1,pA0,pA1,NT-1,false,false,false); RESC();
  { float sacc=pB0[0]+pB0[1]; _Pragma("unroll") for(int r=2;r<16;++r)sacc+=pB0[r]; _Pragma("unroll") for(int r=0;r<16;++r)sacc+=pB1[r]; l_reg+=sacc;
    pw0=(u32x4){PKW(pB0,0),PKW(pB0,2),PKW(pB0,4),PKW(pB0,6)};pw1=(u32x4){PKW(pB0,8),PKW(pB0,10),PKW(pB0,12),PKW(pB0,14)};pw2=(u32x4){PKW(pB1,0),PKW(pB1,2),PKW(pB1,4),PKW(pB1,6)};pw3=(u32x4){PKW(pB1,8),PKW(pB1,10),PKW(pB1,12),PKW(pB1,14)};
    SBAR(); pv(o,vb0+sl_cur,PAF(0),PAF(1),PAF(2),PAF(3)); }
  #undef PKW
  #undef PAF
  #undef VFR
  #undef PIN
  #undef MX3
  #undef GAPA
  #undef GAPB
  #undef EX
  #undef VRD
  #undef KRD
  #undef STEP
  #undef ENDW
  {auto rr=__builtin_amdgcn_permlane32_swap(__float_as_uint(l_reg),__float_as_uint(l_reg),false,false);l_reg=__uint_as_float(rr[0])+__uint_as_float(rr[1]);}
  if(hi==0)wsf[32+r32]=l_reg;asm volatile("s_waitcnt lgkmcnt(0)":::"memory");
  float rli[16];
  #pragma unroll
  for(int r=0;r<16;++r)rli[r]=__builtin_amdgcn_rcpf(wsf[32+crow(r,hi)]);
  bf16*Ow=Ob+(long)(q0+wid*QBLK)*OP+h*D;
  { bf16*stg=(bf16*)(shm+LDS_OST)+wid*2048;
    #pragma unroll
    for(int r=0;r<16;++r){const int orow=crow(r,hi);
      #pragma unroll
      for(int d0=0;d0<2;++d0)stg[orow*64+d0*32+r32]=__float2bfloat16(o[d0][r]*rli[r]);}
    asm volatile("s_waitcnt lgkmcnt(0)":::"memory");
    #pragma unroll
    for(int i=0;i<4;++i){const int row=i*8+(lane>>3),ch=lane&7; const u32x4 v=*(const u32x4*)(stg+row*64+ch*8); ATTN_STORE16(Ow+(long)row*OP+ch*8,v);} }
  asm volatile("s_waitcnt lgkmcnt(0)\n\ts_barrier":::"memory");
  #undef DMA_K
  #undef DMA_V
  #undef CMASK
  #undef START
  #undef RESC
  #undef ROT
}
constexpr int ATTN_LDS_BYTES=LDS_BYTES;
#undef SBAR
#undef WAIT_BAR
}

namespace pg8 {
struct SchedX {
    StaticOrder so; int extra, xpm0, xpn0, xnn; int rev = 0;
    __device__ bool next(int i, Unit& u) const {
        if (rev) { if (i >= rev) return false; return so.next(rev - 1 - i, u); }
        const long L = (long)i * so.G + so.c;
        if (L < so.nwg) return so.next(i, u);
        const int r = (int)(L - so.nwg); if (r >= extra) return false;
        u.pm = xpm0 + r / xnn; u.pn = xpn0 + r % xnn; return true;
    }
    __device__ __forceinline__ void a_ready(const Unit&) const {}
    __device__ __forceinline__ void done(const Unit&) const {}
};

struct SchedSsm {
    int total, G, c, mode;
    __device__ bool next(int i, Unit& u) const {
        const int L = i * G + c; if (L >= total) return false;
        if (mode == 0) { const int g = L / 5; u.pm = L; u.pn = g; }
        else { const int g = L >> 3; u.pm = g * 5 + ((L >> 1) & 3); u.pn = g * 2 + (L & 1); }
        return true;
    }
    __device__ __forceinline__ void a_ready(const Unit&) const {}
    __device__ __forceinline__ void done(const Unit&) const {}
};
struct EpiS {
    static constexpr bool PERM = true, AFTER_DRAIN = false;
    float* S;
    __device__ __forceinline__ void operator()(const f32x4 (&acc)[2][2][4][2], const Unit& u, int wr, int wc, int fr, int fq) const {
        const int row0 = u.pm * BM + wr * 64 + fr; const int col0 = wc * 32 + 8 * fq;
#pragma unroll
        for (int ai = 0; ai < 2; ++ai)
#pragma unroll
            for (int m = 0; m < 4; ++m) { float* rowp = S + (size_t)(row0 + ai * HALF + m * 16) * 256 + col0;
#pragma unroll
                for (int bj = 0; bj < 2; ++bj) { *(f32x4*)(rowp + bj * HALF) = acc[ai][bj][m][0]; *(f32x4*)(rowp + bj * HALF + 4) = acc[ai][bj][m][1]; } }
    }
};
__device__ __forceinline__ float gelu_tanh_(float x) { const float t = x * (-2.302208198f - 0.10294324f * x * x); return x * __builtin_amdgcn_rcpf(1.0f + __builtin_amdgcn_exp2f(t)); }
struct EpiY {
    static constexpr bool PERM = true, AFTER_DRAIN = false;
    bf16_t* YG; const bf16_t* UH; const float* dd;
    __device__ __forceinline__ void operator()(const f32x4 (&acc)[2][2][4][2], const Unit& u, int wr, int wc, int fr, int fq) const {
        const int g = u.pm / 5, pmq = u.pm - 5 * g, pnq = u.pn - 2 * g;
        const int h0 = 8 * (fq & 1);
        const f32x4 d0 = *(const f32x4*)(dd + g * 16 + h0), d1 = *(const f32x4*)(dd + g * 16 + h0 + 4);
#pragma unroll
        for (int ai = 0; ai < 2; ++ai)
#pragma unroll
            for (int m = 0; m < 4; ++m) { const int n = pmq * BM + ai * HALF + wr * 64 + m * 16 + fr;
#pragma unroll
                for (int bj = 0; bj < 2; ++bj) { const int t = (pnq * BM + bj * HALF + wc * 32 + 8 * fq) >> 4;
                    const u32x4 uw = *(const u32x4*)(UH + ((size_t)(g * 1280 + n)) * 768 + t * 16 + h0);
                    f32x4 v0 = acc[ai][bj][m][0], v1 = acc[ai][bj][m][1];
                    v0[0] += d0[0] * __builtin_bit_cast(float, uw.x << 16); v0[1] += d0[1] * __builtin_bit_cast(float, uw.x & 0xffff0000u);
                    v0[2] += d0[2] * __builtin_bit_cast(float, uw.y << 16); v0[3] += d0[3] * __builtin_bit_cast(float, uw.y & 0xffff0000u);
                    v1[0] += d1[0] * __builtin_bit_cast(float, uw.z << 16); v1[1] += d1[1] * __builtin_bit_cast(float, uw.z & 0xffff0000u);
                    v1[2] += d1[2] * __builtin_bit_cast(float, uw.w << 16); v1[3] += d1[3] * __builtin_bit_cast(float, uw.w & 0xffff0000u);
                    u32x4 w; w.x = cvt_pk_bf16(gelu_tanh_(v0[0]), gelu_tanh_(v0[1])); w.y = cvt_pk_bf16(gelu_tanh_(v0[2]), gelu_tanh_(v0[3]));
                    w.z = cvt_pk_bf16(gelu_tanh_(v1[0]), gelu_tanh_(v1[1])); w.w = cvt_pk_bf16(gelu_tanh_(v1[2]), gelu_tanh_(v1[3]));
                    *(u32x4*)(YG + (size_t)(n * 32 + t) * 512 + g * 16 + h0) = w; } }
    }
};

__device__ __forceinline__ float sigm_(float x) { return __builtin_amdgcn_rcpf(1.0f + __builtin_amdgcn_exp2f(-1.4426950408889634f * x)); }
__device__ __forceinline__ float bflo_(unsigned w) { return __builtin_bit_cast(float, w << 16); }
__device__ __forceinline__ float bfhi_(unsigned w) { return __builtin_bit_cast(float, w & 0xffff0000u); }
#define PG8_UNPACK8(dst0, dst1, WW) do { dst0[0] = bflo_(WW[0]); dst0[1] = bfhi_(WW[0]); dst0[2] = bflo_(WW[1]); dst0[3] = bfhi_(WW[1]); dst1[0] = bflo_(WW[2]); dst1[1] = bfhi_(WW[2]); dst1[2] = bflo_(WW[3]); dst1[3] = bfhi_(WW[3]); } while (0)
#define PG8_PACK8(WW, V0, V1) do { WW[0] = cvt_pk_bf16(V0[0], V0[1]); WW[1] = cvt_pk_bf16(V0[2], V0[3]); WW[2] = cvt_pk_bf16(V1[0], V1[1]); WW[3] = cvt_pk_bf16(V1[2], V1[3]); } while (0)
template <int MODE> struct EpiF {
    static constexpr bool PERM = true, AFTER_DRAIN = false;
    bf16_t* O; int ldc; const float* bias; const bf16_t* X; int ldx; const bf16_t* T;
    __device__ __forceinline__ void operator()(const f32x4 (&acc)[2][2][4][2], const Unit& u, int wr, int wc, int fr, int fq) const {
        const int row0 = u.pm * BM + wr * 64 + fr; const int col0 = u.pn * BM + wc * 32 + 8 * fq;
        f32x4 bv[2][2];
#pragma unroll
        for (int bj = 0; bj < 2; ++bj)
#pragma unroll
            for (int n = 0; n < 2; ++n) bv[bj][n] = (MODE == 1) ? *(const f32x4*)(bias + col0 + bj * HALF + 4 * n) : (f32x4){0.f, 0.f, 0.f, 0.f};
#pragma unroll
        for (int ai = 0; ai < 2; ++ai)
#pragma unroll
            for (int m = 0; m < 4; ++m) { const size_t row = (size_t)(row0 + ai * HALF + m * 16);
#pragma unroll
                for (int bj = 0; bj < 2; ++bj) { const int col = col0 + bj * HALF;
                    f32x4 v0 = acc[ai][bj][m][0] + bv[bj][0], v1 = acc[ai][bj][m][1] + bv[bj][1];
                    const u32x4 xw = *(const u32x4*)(X + row * ldx + col); f32x4 x0, x1; PG8_UNPACK8(x0, x1, xw);
                    if (MODE == 1) {
#pragma unroll
                        for (int e = 0; e < 4; ++e) { v0[e] = x0[e] * sigm_(v0[e]); v1[e] = x1[e] * sigm_(v1[e]); }
                    } else {
#pragma unroll
                        for (int e = 0; e < 4; ++e) { v0[e] = x0[e] * v0[e]; v1[e] = x1[e] * v1[e]; }
                        if (MODE == 3) { const u32x4 tw = *(const u32x4*)(T + row * ldc + col); f32x4 t0, t1; PG8_UNPACK8(t0, t1, tw); v0 += t0; v1 += t1; }
                    }
                    u32x4 w; PG8_PACK8(w, v0, v1); *(u32x4*)(O + row * ldc + col) = w; } }
    }
};
struct EpiX1 {
    static constexpr bool PERM = true, AFTER_DRAIN = false;
    const float* x; bf16_t* MIX; bf16_t* XG; const float* g1; const float* gm; float* rowss;
    int ldm;
    __device__ __forceinline__ void operator()(const f32x4 (&acc)[2][2][4][2], const Unit& u, int wr, int wc, int fr, int fq) const {
        const int row0 = u.pm * BM + wr * 64 + fr; const int col0 = u.pn * BM + wc * 32 + 8 * fq; const int b = u.pm >> 3;
        f32x4 gv[2][2], mv[2][2];
#pragma unroll
        for (int bj = 0; bj < 2; ++bj)
#pragma unroll
            for (int n = 0; n < 2; ++n) { gv[bj][n] = *(const f32x4*)(g1 + (size_t)b * ldm + col0 + bj * HALF + 4 * n); mv[bj][n] = *(const f32x4*)(gm + (size_t)b * 1024 + col0 + bj * HALF + 4 * n); }
#pragma unroll
        for (int ai = 0; ai < 2; ++ai)
#pragma unroll
            for (int m = 0; m < 4; ++m) { const size_t row = (size_t)(row0 + ai * HALF + m * 16); float ss = 0.f;
#pragma unroll
                for (int bj = 0; bj < 2; ++bj) { const size_t off = row * 1024 + col0 + bj * HALF;
                    const f32x4 xa = *(const f32x4*)(x + off), xb = *(const f32x4*)(x + off + 4);
                    const f32x4 d0 = gv[bj][0] * acc[ai][bj][m][0], d1 = gv[bj][1] * acc[ai][bj][m][1]; const f32x4 r0 = xa + d0, r1 = xb + d1;
                    { u32x4 wd; PG8_PACK8(wd, d0, d1); *(u32x4*)(MIX + off) = wd; }
                    ss += (r0[0] * r0[0] + r0[1] * r0[1]) + (r0[2] * r0[2] + r0[3] * r0[3]) + (r1[0] * r1[0] + r1[1] * r1[1]) + (r1[2] * r1[2] + r1[3] * r1[3]);
                    const f32x4 h0 = r0 * mv[bj][0], h1 = r1 * mv[bj][1]; u32x4 w; PG8_PACK8(w, h0, h1); *(u32x4*)(XG + off) = w; }
                ss += __shfl_xor(ss, 16); ss += __shfl_xor(ss, 32);
                if (fq == 0) atomicAdd(rowss + row, ss); }
    }
};
struct EpiMlp1 {
    static constexpr bool PERM = true, AFTER_DRAIN = false;
    bf16_t* O; const float* rowss; const float* shb;
    __device__ __forceinline__ void operator()(const f32x4 (&acc)[2][2][4][2], const Unit& u, int wr, int wc, int fr, int fq) const {
        const int row0 = u.pm * BM + wr * 64 + fr; const int col0 = u.pn * BM + wc * 32 + 8 * fq; const int b = u.pm >> 3;
        f32x4 bv[2][2];
#pragma unroll
        for (int bj = 0; bj < 2; ++bj)
#pragma unroll
            for (int n = 0; n < 2; ++n) bv[bj][n] = *(const f32x4*)(shb + (size_t)b * 4096 + col0 + bj * HALF + 4 * n);
#pragma unroll
        for (int ai = 0; ai < 2; ++ai)
#pragma unroll
            for (int m = 0; m < 4; ++m) { const size_t row = (size_t)(row0 + ai * HALF + m * 16);
                const float rstd = 1.0f / sqrtf(rowss[row] * (1.0f / 1024.0f) + 1e-6f);
#pragma unroll
                for (int bj = 0; bj < 2; ++bj) { f32x4 v0 = acc[ai][bj][m][0] * rstd + bv[bj][0], v1 = acc[ai][bj][m][1] * rstd + bv[bj][1];
#pragma unroll
                    for (int e = 0; e < 4; ++e) { const float a = fmaxf(v0[e], 0.f), c = fmaxf(v1[e], 0.f); v0[e] = a * a; v1[e] = c * c; }
                    u32x4 w; PG8_PACK8(w, v0, v1); *(u32x4*)(O + row * 4096 + col0 + bj * HALF) = w; } }
    }
};
struct EpiOut {
    static constexpr bool PERM = true, AFTER_DRAIN = false;
    const float* x; const bf16_t* MIX; float* out; const float* g2; const float* b2; int ldm;
    __device__ __forceinline__ void operator()(const f32x4 (&acc)[2][2][4][2], const Unit& u, int wr, int wc, int fr, int fq) const {
        const int row0 = u.pm * BM + wr * 64 + fr; const int col0 = u.pn * BM + wc * 32 + 8 * fq; const int b = u.pm >> 3;
        f32x4 gv[2][2], bv[2][2];
#pragma unroll
        for (int bj = 0; bj < 2; ++bj)
#pragma unroll
            for (int n = 0; n < 2; ++n) { gv[bj][n] = *(const f32x4*)(g2 + (size_t)b * ldm + col0 + bj * HALF + 4 * n); bv[bj][n] = *(const f32x4*)(b2 + col0 + bj * HALF + 4 * n); }
#pragma unroll
        for (int ai = 0; ai < 2; ++ai)
#pragma unroll
            for (int m = 0; m < 4; ++m) { const size_t row = (size_t)(row0 + ai * HALF + m * 16);
#pragma unroll
                for (int bj = 0; bj < 2; ++bj) { const size_t off = row * 1024 + col0 + bj * HALF; float* p = out + off;
                    const u32x4 mw = *(const u32x4*)(MIX + off); f32x4 m0, m1; PG8_UNPACK8(m0, m1, mw);
                    const f32x4 xa = *(const f32x4*)(x + off) + m0, xb = *(const f32x4*)(x + off + 4) + m1;
                    *(f32x4*)p = xa + gv[bj][0] * (acc[ai][bj][m][0] + bv[bj][0]); *(f32x4*)(p + 4) = xb + gv[bj][1] * (acc[ai][bj][m][1] + bv[bj][1]); }
                asm volatile("" ::: "memory"); }
    }
};

template <size_t OQ, size_t OKC, size_t OVC, size_t OUH, size_t OSGA, size_t OSGS, size_t ORC, size_t ORS> struct EpiIn {
    static constexpr bool PERM = true, AFTER_DRAIN = false;
    unsigned char* wsb; const float *gq, *gk;
    __device__ __forceinline__ void operator()(const f32x4 (&acc)[2][2][4][2], const Unit& u, int wr, int wc, int fr, int fq) const {
        bf16_t* const Q = (bf16_t*)(wsb + OQ); bf16_t* const KC = (bf16_t*)(wsb + OKC); bf16_t* const VC = (bf16_t*)(wsb + OVC); bf16_t* const UH = (bf16_t*)(wsb + OUH); bf16_t* const SGA = (bf16_t*)(wsb + OSGA); bf16_t* const SGS = (bf16_t*)(wsb + OSGS);
        const float* const RC = (const float*)(wsb + ORC); const float* const RS = (const float*)(wsb + ORS);
        const int pn = u.pn; const bool lat = u.pm < 128;
        const int rowt = u.pm * BM + wr * 64 + fr;
        if (pn < 5) {
            const bool isq = pn < 4; const float* gn = isq ? gq : gk;
            f32x4 gg[2][2];
#pragma unroll
            for (int bj = 0; bj < 2; ++bj)
#pragma unroll
                for (int n = 0; n < 2; ++n) gg[bj][n] = *(const f32x4*)(gn + 32 * bj + 16 * n + 4 * fq);
#pragma unroll
            for (int ai = 0; ai < 2; ++ai)
#pragma unroll
                for (int m = 0; m < 4; ++m) { const int row = rowt + ai * HALF + m * 16;
                    float ss = 0.f;
#pragma unroll
                    for (int bj = 0; bj < 2; ++bj)
#pragma unroll
                        for (int n = 0; n < 2; ++n) { const f32x4 v = acc[ai][bj][m][n]; ss += (v[0] * v[0] + v[1] * v[1]) + (v[2] * v[2] + v[3] * v[3]); }
                    ss += __shfl_xor(ss, 16); ss += __shfl_xor(ss, 32);
                    const float r = (isq ? 0.18033688011112042f : 1.0f) / sqrtf(ss * (1.0f / 64.0f) + 1e-6f);
                    const int t = row & 2047;
                    bf16_t* dst;
                    if (isq) dst = Q + (size_t)row * 1024 + pn * 256 + wc * 64 + 8 * fq;
                    else { const int rc = row - 32768; const size_t krow = lat ? (size_t)(row >> 11) * 2304 + t : (size_t)(rc >> 8) * 2304 + 2048 + (rc & 255); dst = KC + krow * 256 + wc * 64 + 8 * fq; }
#pragma unroll
                    for (int bj = 0; bj < 2; ++bj) { f32x4 x1 = acc[ai][bj][m][0] * r * gg[bj][0], x2 = acc[ai][bj][m][1] * r * gg[bj][1];
                        if (lat) { const int pos = bj == 0 ? (t >> 6) : (t & 63); const f32x4 c4 = *(const f32x4*)(RC + pos * 16 + 4 * fq), s4 = *(const f32x4*)(RS + pos * 16 + 4 * fq);
                            const f32x4 o1 = x1 * c4 - x2 * s4, o2 = x2 * c4 + x1 * s4; x1 = o1; x2 = o2; }
                        u32x4 w; PG8_PACK8(w, x1, x2); *(u32x4*)(dst + 32 * bj) = w; }
                    asm volatile("" ::: "memory"); }
        } else if (pn == 5) {
#pragma unroll
            for (int ai = 0; ai < 2; ++ai)
#pragma unroll
                for (int m = 0; m < 4; ++m) { const int row = rowt + ai * HALF + m * 16; const int rc = row - 32768;
                    const size_t krow = lat ? (size_t)(row >> 11) * 2304 + (row & 2047) : (size_t)(rc >> 8) * 2304 + 2048 + (rc & 255);
#pragma unroll
                    for (int bj = 0; bj < 2; ++bj) { u32x4 w; PG8_PACK8(w, acc[ai][bj][m][0], acc[ai][bj][m][1]); *(u32x4*)(VC + krow * 256 + bj * HALF + wc * 32 + 8 * fq) = w; } }
        } else if (pn < 8) {
#pragma unroll
            for (int ai = 0; ai < 2; ++ai)
#pragma unroll
                for (int m = 0; m < 4; ++m) { const int row = rowt + ai * HALF + m * 16; const int mc = lat ? row : row - 32768; const int nidx = (lat ? 0 : 1024) + (mc >> 5), sidx = mc & 31;
#pragma unroll
                    for (int bj = 0; bj < 2; ++bj) { const int ch0 = 256 * (pn - 6) + bj * HALF + wc * 32 + 8 * fq;
                        u32x4 w; PG8_PACK8(w, acc[ai][bj][m][0], acc[ai][bj][m][1]); *(u32x4*)(UH + ((size_t)((ch0 >> 4) * 1280 + nidx)) * 768 + sidx * 16 + (ch0 & 15)) = w; } }
        } else {
            bf16_t* G_ = (pn < 12) ? SGA : SGS;
#pragma unroll
            for (int ai = 0; ai < 2; ++ai)
#pragma unroll
                for (int m = 0; m < 4; ++m) { const int row = rowt + ai * HALF + m * 16;
#pragma unroll
                    for (int bj = 0; bj < 2; ++bj) { f32x4 v0 = acc[ai][bj][m][0], v1 = acc[ai][bj][m][1];
#pragma unroll
                        for (int e = 0; e < 4; ++e) { v0[e] = sigm_(v0[e]); v1[e] = sigm_(v1[e]); }
                        u32x4 w; PG8_PACK8(w, v0, v1); *(u32x4*)(G_ + (size_t)row * 1024 + (pn & 3) * 256 + bj * HALF + wc * 32 + 8 * fq) = w; } }
        }
    }
};

struct EpiMerge {
    static constexpr bool PERM = true, AFTER_DRAIN = false;
    bf16_t* O; const bf16_t* SGA; const bf16_t* SGS;
    __device__ __forceinline__ void mid(f32x4 (&acc)[2][2][4][2], const Unit& u, int wr, int wc, int fr, int fq) const {
        int row0 = u.pm * BM + wr * 64 + fr; int col0 = u.pn * BM + wc * 32 + 8 * fq;
        asm volatile("" : "+v"(row0), "+v"(col0));
#pragma unroll
        for (int ai = 0; ai < 2; ++ai)
#pragma unroll
            for (int m = 0; m < 4; ++m) { const size_t row = (size_t)(row0 + ai * HALF + m * 16);
#pragma unroll
                for (int bj = 0; bj < 2; ++bj) { const size_t off = row * 1024 + col0 + bj * HALF;
                    const u32x4 aw = *(const u32x4*)(SGA + off), sw = *(const u32x4*)(SGS + off); f32x4 a0, a1, s0, s1; PG8_UNPACK8(a0, a1, aw); PG8_UNPACK8(s0, s1, sw);
#pragma unroll
                    for (int e = 0; e < 4; ++e) { acc[ai][bj][m][0][e] *= s0[e] * __builtin_amdgcn_rcpf(fmaxf(a0[e], 1e-30f)); acc[ai][bj][m][1][e] *= s1[e] * __builtin_amdgcn_rcpf(fmaxf(a1[e], 1e-30f)); } }
                asm volatile("" : "+v"(acc[ai][0][m][0]), "+v"(acc[ai][0][m][1]), "+v"(acc[ai][1][m][0]), "+v"(acc[ai][1][m][1]) :: "memory"); }
    }
    __device__ __forceinline__ void operator()(const f32x4 (&acc)[2][2][4][2], const Unit& u, int wr, int wc, int fr, int fq) const {
        const int row0 = u.pm * BM + wr * 64 + fr; const int col0 = u.pn * BM + wc * 32 + 8 * fq;
#pragma unroll
        for (int ai = 0; ai < 2; ++ai)
#pragma unroll
            for (int m = 0; m < 4; ++m) { const size_t row = (size_t)(row0 + ai * HALF + m * 16);
#pragma unroll
                for (int bj = 0; bj < 2; ++bj) { const size_t off = row * 1024 + col0 + bj * HALF;
                    const u32x4 aw = *(const u32x4*)(SGA + off); f32x4 a0, a1; PG8_UNPACK8(a0, a1, aw);
                    const f32x4 v0 = acc[ai][bj][m][0] * a0, v1 = acc[ai][bj][m][1] * a1;
                    u32x4 w; PG8_PACK8(w, v0, v1); *(u32x4*)(O + off) = w; } }
    }
};
}

constexpr int NB = 16, SEQ = 2048, DM = 1024, NCTX = 256;
constexpr int MLAT = NB * SEQ, MCTX = NB * NCTX, MALL = MLAT + MCTX;
constexpr int WIN = 4096, NH = 16, NKV = 4, HD = 64, DSSM = 512, NG = 32, SGRP = 16, PST = 64, DFF = 4096;
constexpr int OFF_Q = 0, OFF_K = 1024, OFF_V = 1280, OFF_U = 1536, OFF_GA = 2048, OFF_GS = 3072;
constexpr int LTOT = NCTX + SEQ;
constexpr float NORM_EPS = 1e-6f;

constexpr size_t MiB = 1u << 20;
constexpr size_t WS_CTL = 0, CTL_ZERO_BYTES = 16 * 1024;
constexpr size_t WS_MV = 128 * 1024;
constexpr size_t WS_ROPEC = 1 * MiB + 432 * 1024, WS_ROPES = 1 * MiB + 436 * 1024;
constexpr size_t WS_KCG = 2 * MiB;
constexpr size_t WS_WIN = 4 * MiB, WS_W1 = 12 * MiB, WS_W2 = 20 * MiB, WS_BCAT = 28 * MiB  , WS_WOUT = 32 * MiB, WS_WGLU = 34 * MiB;
constexpr size_t WS_H = 36 * MiB;
constexpr size_t WS_P = 108 * MiB;
constexpr size_t WS_Q = 108 * MiB;
constexpr size_t WS_KC = 172 * MiB, WS_VC = 190 * MiB;
constexpr size_t WS_SGA = 208 * MiB, WS_SGS = 272 * MiB;
constexpr size_t WS_UH = 336 * MiB;
constexpr size_t WS_YG = 396 * MiB;
constexpr size_t WS_X1 = 364 * MiB;
constexpr size_t WS_BTC = 460 * MiB;
constexpr size_t WS_BTA = 484 * MiB;
constexpr size_t WS_END = 492 * MiB;
constexpr size_t WS_S = 36 * MiB;
constexpr size_t WS_MG = 36 * MiB;
constexpr int ACAT_LD = 1536;
constexpr int TC = 32, NROW_G = 1280;
constexpr int CW_BAR = 0;
constexpr int CW_CNT = 3584;
constexpr size_t WS_ROWSS = 640 * 1024;
constexpr size_t WS_SHB = 768 * 1024;
constexpr size_t WS_GM = 1 * MiB;

#define GAS __attribute__((address_space(1)))
#define LAS __attribute__((address_space(3)))
typedef unsigned short bf16;
typedef unsigned v4u __attribute__((ext_vector_type(4)));
typedef unsigned v2u __attribute__((ext_vector_type(2)));
typedef float f32x4 __attribute__((ext_vector_type(4)));
typedef float f32x2 __attribute__((ext_vector_type(2)));
#define DEV __device__ __forceinline__
#define LDS_WAIT() asm volatile("s_waitcnt lgkmcnt(0)" ::: "memory")
DEV unsigned f2bf(float f) { unsigned u = __builtin_bit_cast(unsigned, f); return (u + 0x7fffu + ((u >> 16) & 1u)) >> 16; }
DEV unsigned pk2(float lo, float hi) { return f2bf(lo) | (f2bf(hi) << 16); }
DEV float bf2f(unsigned b) { return __builtin_bit_cast(float, b << 16); }
DEV float bflo(unsigned w) { return __builtin_bit_cast(float, w << 16); }
DEV float bfhi(unsigned w) { return __builtin_bit_cast(float, w & 0xffff0000u); }
DEV float wave_sum(float v) {
#pragma unroll
    for (int o = 1; o < 64; o <<= 1) v += __shfl_xor(v, o);
    return v;
}
DEV float sigmoidf_(float x) { return 1.0f / (1.0f + expf(-x)); }
DEV float gelu_tanh(float x) { const float u = 0.7978845608028654f * (x + 0.044715f * x * x * x); return 0.5f * x * (1.0f + tanhf(u)); }


DEV void cnt_arrive(unsigned* cnt) {
    asm volatile("s_waitcnt vmcnt(0)" ::: "memory");
    __syncthreads();
    if (threadIdx.x == 0) { __builtin_amdgcn_fence(__ATOMIC_RELEASE, "agent"); asm volatile("s_waitcnt vmcnt(0)" ::: "memory"); __hip_atomic_fetch_add(cnt, 1u, __ATOMIC_RELAXED, __HIP_MEMORY_SCOPE_AGENT); }
}
DEV void cnt_wait(unsigned* cnt, unsigned target, unsigned* tmo) {
    if (threadIdx.x == 0) {
        unsigned sp = 0;
        while (__hip_atomic_load(cnt, __ATOMIC_RELAXED, __HIP_MEMORY_SCOPE_AGENT) < target) { __builtin_amdgcn_s_sleep(2); if (++sp > (1u << 22)) { atomicAdd(tmo, 1u); break; } }
        __builtin_amdgcn_fence(__ATOMIC_ACQUIRE, "agent"); asm volatile("s_waitcnt vmcnt(0)" ::: "memory");
    }
    __syncthreads();
}

struct Args { const float* in[28]; float* out; unsigned char* ws; int ph_lo, ph_hi, li, pad; };

template <bool QKPERM> DEV void transpose_item(const float* W, int K, int N, bf16* WT, LAS float* scr, int item, int lane, int ldt = 0) {
    if (ldt == 0) ldt = K;
    const int nblk = N / 32, kb = item / nblk, nb = item % nblk, k0 = 64 * kb, n0 = 32 * nb;
    float wv[32];
#pragma unroll
    for (int i = 0; i < 32; ++i) { const int kk = 2 * i + (lane >> 5); wv[i] = W[(size_t)(k0 + kk) * N + n0 + (lane & 31)]; }
#pragma unroll
    for (int i = 0; i < 32; ++i) { const int kk = 2 * i + (lane >> 5); scr[kk * 33 + (lane & 31)] = wv[i]; }
    LDS_WAIT(); asm volatile("" ::: "memory");
    const int c = lane & 7;
#pragma unroll
    for (int j = 0; j < 4; ++j) { const int n = (lane >> 3) + 8 * j; const LAS float* s = scr + (8 * c) * 33 + n;
        v4u o; o.x = pk2(s[0 * 33], s[1 * 33]); o.y = pk2(s[2 * 33], s[3 * 33]); o.z = pk2(s[4 * 33], s[5 * 33]); o.w = pk2(s[6 * 33], s[7 * 33]);
        int nr = n0 + n; if (QKPERM && nr < 1280) { const int cl = nr & 255; nr = (nr & ~255) + 128 * ((cl >> 5) & 1) + 32 * (cl >> 6) + 8 * ((cl >> 2) & 3) + 4 * ((cl >> 4) & 1) + (cl & 3); }
        *(v4u*)(WT + (size_t)nr * ldt + k0 + 8 * c) = o; }
    LDS_WAIT(); asm volatile("" ::: "memory");
}

typedef float f32x16m __attribute__((ext_vector_type(16)));
DEV void ph_modvec(const Args& a, LAS unsigned char* lds, int tid, int lane, int wave, int bid, int G) {
    const float* c = a.in[1]; const float* cc = a.in[3]; const float* wm = a.in[4]; const float* bm = a.in[5];
    float* MV = (float*)(a.ws + WS_MV);
    LAS float* SC = (LAS float*)lds;
    LAS float* PR = (LAS float*)(lds + 71680);
    const int li = lane & 31, lk = lane >> 5;
    for (int slab = bid; slab < 256; slab += G) {
        float bv[64];
        { const float* wp = wm + (size_t)(128 * wave + lk) * 6144 + slab * 24 + (li < 24 ? li : 0);
#pragma unroll
          for (int t = 0; t < 64; ++t) bv[t] = wp[(size_t)(2 * t) * 6144]; }
        if (slab == bid) { for (int e = tid; e < 17 * 1024; e += 512) { const float cv = (e < 16 * 1024) ? c[e] : cc[e - 16 * 1024]; SC[(e >> 10) * 1025 + (e & 1023)] = cv / (1.0f + expf(-cv)); } }
        __syncthreads();
        f32x16m acc = {0.f, 0.f, 0.f, 0.f, 0.f, 0.f, 0.f, 0.f, 0.f, 0.f, 0.f, 0.f, 0.f, 0.f, 0.f, 0.f};
        const LAS float* sp = SC + (li < 17 ? li : 0) * 1025 + 128 * wave + lk;
#pragma unroll
        for (int t = 0; t < 64; ++t) { const float av = (li < 17) ? sp[2 * t] : 0.f; const float bw = (li < 24) ? bv[t] : 0.f; acc = __builtin_amdgcn_mfma_f32_32x32x2f32(av, bw, acc, 0, 0, 0); }
#pragma unroll
        for (int r = 0; r < 16; ++r) { const int row = (r & 3) + 8 * (r >> 2) + 4 * lk; if (row < 17 && li < 24) PR[(wave * 17 + row) * 24 + li] = acc[r]; }
        __syncthreads();
        if (tid < 408) { float sum = bm[slab * 24 + (tid % 24)];
#pragma unroll
            for (int w = 0; w < 8; ++w) sum += PR[w * 408 + tid];
            MV[(tid / 24) * 6144 + slab * 24 + (tid % 24)] = sum; }
        __syncthreads();
    }
}

DEV void ph_prologue(const Args& a, LAS unsigned char* lds, int tid, int lane, int wave, int bid, int G) {
    unsigned char* ws = a.ws;
    LAS float* scr = (LAS float*)(lds + wave * 16384);
    const int gw = bid * 8 + wave, NGW = G * 8;
    for (int it = gw; it < 16 * 128; it += NGW) transpose_item<true>(a.in[8], 1024, 4096, (bf16*)(ws + WS_WIN), scr, it, lane);
    {
        const int gt = bid * 512 + tid;
        for (int e = gt; e < (128 + 256) * 1024 / 16; e += G * 512) ((f32x4*)(ws + WS_ROWSS))[e] = (f32x4){0.f, 0.f, 0.f, 0.f};
        if (gt < 1024) {
            const int pos = gt >> 4, j = gt & 15;
            const float invf = powf(10000.0f, -(float)j / 16.0f);
            const float ang = (float)pos * invf;
            ((float*)(ws + WS_ROPEC))[gt] = cosf(ang); ((float*)(ws + WS_ROPES))[gt] = sinf(ang);
        }
    }
}

DEV void ph_transposes_rest(const Args& a, LAS unsigned char* lds, int lane, int wave, int gw, int NGW) {
    unsigned char* ws = a.ws; LAS float* scr = (LAS float*)(lds + wave * 16384);
    constexpr int I_1 = 16 * 128, I_2 = 64 * 32, I_A = 16 * 32, I_O = 16 * 32, I_S = 8 * 32, I_G = 8 * 16;
    constexpr int NITEMS = I_1 + I_2 + I_A + I_O + I_S + I_G;
    for (int it = gw; it < NITEMS; it += NGW) {
        int r = it;
        if (r < I_1) { transpose_item<false>(a.in[24], 1024, 4096, (bf16*)(ws + WS_W1), scr, r, lane); continue; } r -= I_1;
        if (r < I_2) { transpose_item<false>(a.in[26], 4096, 1024, (bf16*)(ws + WS_W2), scr, r, lane); continue; } r -= I_2;
        if (r < I_A) { transpose_item<false>(a.in[21], 1024, 1024, (bf16*)(ws + WS_BCAT) + 512, scr, r, lane, 1536); continue; } r -= I_A;
        if (r < I_O) { transpose_item<false>(a.in[23], 1024, 1024, (bf16*)(ws + WS_WOUT), scr, r, lane); continue; } r -= I_O;
        if (r < I_S) { transpose_item<false>(a.in[22], 512, 1024, (bf16*)(ws + WS_BCAT), scr, r, lane, 1536); continue; } r -= I_S;
        transpose_item<false>(a.in[19], 512, 512, (bf16*)(ws + WS_WGLU), scr, r, lane);
    }
}

DEV void ph_normmod(const Args& a, int lane, int wave, int bid, int G) {
    const int gw = bid * 8 + wave, NGW = G * 8;
    const float* MV = (const float*)(a.ws + WS_MV); const float* gn = a.in[6]; bf16* H = (bf16*)(a.ws + WS_H);
    const int rpw = (MALL + NGW - 1) / NGW;
    const int m0 = gw * rpw, m1 = (m0 + rpw < MALL) ? m0 + rpw : MALL;
    f32x4 nx[3][4];
#define NM_LOAD(slot, m_) do { const int mm_ = (m_); if (mm_ < m1) { const float* xr_ = (mm_ < MLAT) ? a.in[0] + (size_t)mm_ * DM : a.in[2] + (size_t)(mm_ - MLAT) * DM; \
        _Pragma("unroll") for (int j = 0; j < 4; ++j) nx[slot][j] = ((const f32x4*)xr_)[lane + 64 * j]; } } while (0)
#define NM_ROW(slot, m_) do { const int mr_ = (m_); if (mr_ < m1) { const float* mv = MV + ((mr_ < MLAT) ? (mr_ / SEQ) : 16) * 6144; \
        f32x4 v[4]; float ss = 0.f; \
        _Pragma("unroll") for (int j = 0; j < 4; ++j) { v[j] = nx[slot][j]; ss += (v[j].x * v[j].x + v[j].y * v[j].y) + (v[j].z * v[j].z + v[j].w * v[j].w); } \
        NM_LOAD(slot, mr_ + 3); \
        const float rstd = 1.0f / sqrtf(wave_sum(ss) * (1.0f / DM) + NORM_EPS); \
        _Pragma("unroll") for (int j = 0; j < 4; ++j) { const int k4 = lane + 64 * j; \
            const f32x4 g4 = ((const f32x4*)gn)[k4], sh = ((const f32x4*)mv)[k4], sc = ((const f32x4*)(mv + 1024))[k4]; \
            const f32x4 h = v[j] * rstd * g4 * (sc + 1.0f) + sh; \
            v2u o; o.x = pk2(h.x, h.y); o.y = pk2(h.z, h.w); ((v2u*)(H + (size_t)mr_ * DM))[k4] = o; } } } while (0)
    NM_LOAD(0, m0); NM_LOAD(1, m0 + 1); NM_LOAD(2, m0 + 2);
    for (int m = m0; m < m1; m += 3) { NM_ROW(0, m); NM_ROW(1, m + 1); NM_ROW(2, m + 2); }
#undef NM_LOAD
#undef NM_ROW
}

DEV void ph_mlp_consts(const Args& a, LAS unsigned char* lds, int tid, int lane, int wave, int bid, int G) {
    const float* MV = (const float*)(a.ws + WS_MV); float* GM = (float*)(a.ws + WS_GM); float* SHB = (float*)(a.ws + WS_SHB);
    for (int e = bid * 512 + tid; e < 16 * 1024; e += G * 512) { const int b = e >> 10, k = e & 1023; GM[e] = a.in[7][k] * (1.0f + MV[b * 6144 + 4096 + k]); }
    LAS float* scr = (LAS float*)(lds + wave * 16384);
    const int gw = bid * 8 + wave, NGW = G * 8; const float* w1 = a.in[24]; const float* b1 = a.in[25];
    for (int it = NGW - 1 - gw; it < 64 * 32; it += NGW) {
        const int cb = it & 63, ks = it >> 6, col = cb * 64 + lane, k0 = ks * 32;
        float w[32];
#pragma unroll
        for (int j = 0; j < 32; ++j) w[j] = w1[(size_t)(k0 + j) * 4096 + col];
        for (int i = lane; i < 16 * 32; i += 64) { const int b = i >> 5, kk = i & 31; scr[i] = MV[b * 6144 + 3072 + k0 + kk]; }
        LDS_WAIT(); asm volatile("" ::: "memory");
        const float bb = (ks == 0) ? b1[col] : 0.f;
#pragma unroll
        for (int b = 0; b < 16; ++b) { float acc = bb;
#pragma unroll
            for (int j4 = 0; j4 < 8; ++j4) { const f32x4 s4 = *(const LAS f32x4*)(scr + b * 32 + 4 * j4); acc += (s4.x * w[4 * j4] + s4.y * w[4 * j4 + 1]) + (s4.z * w[4 * j4 + 2] + s4.w * w[4 * j4 + 3]); }
            atomicAdd(SHB + b * 4096 + col, acc); }
        LDS_WAIT(); asm volatile("" ::: "memory");
    }
}

DEV void ph_attn(const Args& a, char* lds_generic, int bid, int G, int r0, int r1) {
    const attn_body::bf16* Q = (const attn_body::bf16*)(a.ws + WS_Q); const attn_body::bf16* KC = (const attn_body::bf16*)(a.ws + WS_KC); const attn_body::bf16* VC = (const attn_body::bf16*)(a.ws + WS_VC);
    attn_body::bf16* AO = (attn_body::bf16*)a.out + 512;
    const int vcu = (G % 8 == 0) ? (bid % 8) * (G / 8) + bid / 8 : bid;
#pragma nounroll
    for (int r = r0; r < r1; ++r) { const int L = vcu + r * G; if (L >= NB * NH * (SEQ / 256)) break;
        const int grp = L >> 5, j = L & 31; const int b = grp >> 2, kvh = grp & 3; const int h = kvh * 4 + (j >> 3), qb = j & 7;
        const attn_body::bf16* kb = KC + (size_t)b * LTOT * 256; const attn_body::bf16* vb = VC + (size_t)b * LTOT * 256;
        attn_body::attn_unit<8, DM, 256, ACAT_LD>(h, qb, Q + (size_t)b * SEQ * DM, kb, vb, kb + (size_t)SEQ * 256, vb + (size_t)SEQ * 256, AO + (size_t)b * SEQ * ACAT_LD, lds_generic);
    }
}

DEV void ssm_disc(const Args& a, int idx, f32x2& av, f32x2& coef) {
    const int dg = idx >> 6;
    const float dt = expf(a.in[13][dg]);
    const float lre = a.in[11][idx], lim = a.in[12][idx];
    const float zr = lre * dt, zi = lim * dt;
    const float ex = expf(zr), sn = sinf(zi), cs = cosf(zi);
    const float sh = sinf(0.5f * zi), em1 = expm1f(zr);
    const float nre = em1 * cs - 2.0f * sh * sh, nim = ex * sn;
    const float den = lre * lre + lim * lim;
    av = (f32x2){ex * cs, ex * sn}; coef = (f32x2){(nre * lre + nim * lim) / den, (nim * lre - nre * lim) / den};
}
DEV f32x2 cmul(f32x2 x, f32x2 y) { return (f32x2){x.x * y.x - x.y * y.y, x.x * y.y + x.y * y.x}; }

DEV void ssm_kc_item(const Args& a, LAS float* scr, int item, int lane) {
    const int g = item / 63, di = item % 63, dl = di - 31;
    LAS f32x2* X = (LAS f32x2*)scr;
    LAS f32x2* Cw = X + 1024;
    const int h = lane >> 2, hq = lane & 3;
    float acc0 = 0.f, acc1 = 0.f, acc2 = 0.f, acc3 = 0.f;
    for (int dir = 0; dir < 2; ++dir) {
        if ((dir == 0 && dl < 0) || (dir == 1 && dl > 0)) continue;
        const int idx = (dir * 32 + g) * 64 + lane; f32x2 av, coef; ssm_disc(a, idx, av, coef);
        int e = dl < 0 ? -dl : dl; f32x2 pw = (f32x2){1.f, 0.f}, bs = av;
        while (e) { if (e & 1) pw = cmul(pw, bs); bs = cmul(bs, bs); e >>= 1; }
        const f32x2 pc = cmul(pw, coef);
#pragma unroll
        for (int hp = 0; hp < 16; ++hp) X[lane * 16 + hp] = cmul(pc, (f32x2){a.in[14][(size_t)idx * 16 + hp], a.in[15][(size_t)idx * 16 + hp]});
#pragma unroll
        for (int hh = 0; hh < 16; ++hh) Cw[hh * 64 + lane] = (f32x2){a.in[16][(size_t)((dir * 32 + g) * 16 + hh) * 64 + lane], a.in[17][(size_t)((dir * 32 + g) * 16 + hh) * 64 + lane]};
        LDS_WAIT(); asm volatile("" ::: "memory");
        for (int p = 0; p < 64; ++p) { const f32x2 c = Cw[h * 64 + p]; const LAS f32x4* xp = (const LAS f32x4*)(X + p * 16 + 4 * hq); const f32x4 xa = xp[0], xb = xp[1];
            acc0 += c.x * xa.x - c.y * xa.y; acc1 += c.x * xa.z - c.y * xa.w; acc2 += c.x * xb.x - c.y * xb.y; acc3 += c.x * xb.z - c.y * xb.w; }
        LDS_WAIT(); asm volatile("" ::: "memory");
    }
    v2u o; o.x = pk2(acc0, acc1); o.y = pk2(acc2, acc3);
    *(v2u*)((bf16*)(a.ws + WS_KCG) + (size_t)item * 256 + h * 16 + 4 * hq) = o;
}

DEV void ssm_expand(const Args& a, LAS unsigned char* lds, int tid, int item) {
    const int g = item >> 3, q = item & 7;
    LAS f32x2* PW = (LAS f32x2*)lds;
    LAS f32x2* BBl = (LAS f32x2*)(lds + 33792);
    LAS f32x2* Cl = (LAS f32x2*)(lds + 33792 + 16384);
    __syncthreads();
    if (tid < 128) {
        const int dir = tid >> 6, p = tid & 63, idx = (dir * 32 + g) * 64 + p;
        f32x2 av, coef; ssm_disc(a, idx, av, coef);
        f32x2 w = (f32x2){1.f, 0.f};
        for (int k = 0; k <= 32; ++k) { PW[tid * 33 + k] = w; w = cmul(w, av); }
#pragma unroll
        for (int h = 0; h < 16; ++h) BBl[tid * 16 + h] = cmul(coef, (f32x2){a.in[14][(size_t)idx * 16 + h], a.in[15][(size_t)idx * 16 + h]});
    }
    for (int e = tid; e < 2048; e += 512) { const int dir = e >> 10, hp = e & 1023; Cl[e] = (f32x2){a.in[16][(size_t)(dir * 32 + g) * 1024 + hp], a.in[17][(size_t)(dir * 32 + g) * 1024 + hp]}; }
    __syncthreads();
    bf16* BtC = (bf16*)(a.ws + WS_BTC) + (size_t)g * 512 * 768; bf16* BtA = (bf16*)(a.ws + WS_BTA) + (size_t)g * 256 * 512; const bf16* KCG = (const bf16*)(a.ws + WS_KCG) + (size_t)g * 63 * 256;
#pragma unroll
    for (int i = 0; i < 8; ++i) { const int cid = tid + 512 * i, row = cid >> 6, tl = row >> 4, h = row & 15, ch = cid & 63, sidx = ch >> 1, half = ch & 1;
        const int di = 4 * q + tl - sidx + 31;
        const v4u val = *(const v4u*)(KCG + (size_t)di * 256 + h * 16 + half * 8);
        *(v4u*)(BtC + (size_t)((4 * q + tl) * 16 + h) * 768 + sidx * 16 + half * 8) = val; }
    for (int e = tid; e < 64 * 128; e += 512) { const int row = e >> 7, pc = e & 127, tl = row >> 4, h = row & 15, t = 4 * q + tl, dir = pc >> 6, p = pc & 63;
        const int pe = dir == 0 ? t + 1 : 32 - t;
        const f32x2 cw = cmul(Cl[(dir * 16 + h) * 64 + p], PW[(dir * 64 + p) * 33 + pe]);
        *(unsigned*)(BtC + (size_t)(t * 16 + h) * 768 + 512 + 2 * pc) = pk2(cw.x, -cw.y); }
    for (int e = tid; e < 32 * 512; e += 512) { const int rl = e >> 9, k = e & 511, r = 32 * q + rl, dir = r >> 7, p = (r >> 1) & 63, ri = r & 1, sidx = k >> 4, hp = k & 15;
        const int pe = dir == 0 ? 31 - sidx : sidx;
        const f32x2 v = cmul(PW[(dir * 64 + p) * 33 + pe], BBl[(dir * 64 + p) * 16 + hp]);
        BtA[(size_t)r * 512 + k] = (bf16)f2bf(ri == 0 ? v.x : v.y); }
    LDS_WAIT();
}

DEV void ph_scan(const Args& a, int lane, int wave, int bid, int G) {
    const float* S = (const float*)(a.ws + WS_S); bf16* UH = (bf16*)(a.ws + WS_UH);
    for (int w = wave * G + bid; w < 1024; w += 8 * G) {
        const int dir = w & 1, g = (w >> 1) & 31, b = w >> 6;
        f32x2 av, coef; ssm_disc(a, (dir * 32 + g) * 64 + lane, av, coef);
        f32x2 a32 = av;
#pragma unroll
        for (int i = 0; i < 5; ++i) a32 = cmul(a32, a32);
        const int col = dir * 128 + 2 * lane;
        const float* Sg = S + (size_t)g * NROW_G * 256 + col; bf16* Ug = UH + (size_t)g * NROW_G * 768 + 512 + col;
        f32x2 H = (f32x2){0.f, 0.f};
        { f32x2 sv[8];
#pragma unroll
          for (int c = 0; c < 8; ++c) { const int cc = dir == 0 ? c : 7 - c; sv[c] = *(const f32x2*)(Sg + (size_t)(1024 + b * 8 + cc) * 256); }
#pragma unroll
          for (int c = 0; c < 8; ++c) { H = cmul(a32, H); H.x += sv[c].x; H.y += sv[c].y; } }
        for (int j0 = 0; j0 < 64; j0 += 8) {
            f32x2 sv[8];
#pragma unroll
            for (int c = 0; c < 8; ++c) { const int j = dir == 0 ? j0 + c : 63 - (j0 + c); sv[c] = *(const f32x2*)(Sg + (size_t)(b * 64 + j) * 256); }
#pragma unroll
            for (int c = 0; c < 8; ++c) { const int j = dir == 0 ? j0 + c : 63 - (j0 + c);
                *(unsigned*)(Ug + (size_t)(b * 64 + j) * 768) = pk2(H.x, H.y);
                H = cmul(a32, H); H.x += sv[c].x; H.y += sv[c].y; }
        }
    }
}
#define XB_TMO      128
#define XB_XCNT(j)  (256  + 64 * (j))
#define XB_XSUB(j)  (1280 + 64 * (j))
#define XB_XGEN(j)  (2304 + 64 * (j))
#define XB_TOP      3328
#define XB_TOPGEN   3392
#define XCD_BAR_WORDS 3456
#define XB_SPIN_CAP (1u << 18)

__device__ __forceinline__ unsigned xb_ld(unsigned* p)              { return __hip_atomic_load(p, __ATOMIC_RELAXED, __HIP_MEMORY_SCOPE_AGENT); }
__device__ __forceinline__ unsigned xb_add(unsigned* p, unsigned v) { return __hip_atomic_fetch_add(p, v, __ATOMIC_RELAXED, __HIP_MEMORY_SCOPE_AGENT); }
__device__ __forceinline__ unsigned xb_xcc_id() { return (unsigned)__builtin_amdgcn_s_getreg((3 << 11) | 20) & 0xFu; }
#define XB_SPIN(cond, bar) do { unsigned _sp = 0; while (cond) { __builtin_amdgcn_s_sleep(1); \
    if ((++_sp & 255u) == 0u) { if (xb_ld(&(bar)[XB_TMO])) break; if (_sp > XB_SPIN_CAP) { atomicAdd(&(bar)[XB_TMO], 1u); break; } } } } while (0)

struct XcdBarrier {
    unsigned* bar; unsigned x;
    volatile LAS unsigned* st;
};

__device__ __forceinline__ XcdBarrier xcd_barrier_post(unsigned* bar, volatile LAS unsigned* st) {
    XcdBarrier b; b.bar = bar; b.x = xb_xcc_id(); b.st = st;
    if (threadIdx.x == 0) (void)xb_add(&bar[XB_XCNT(b.x)], 1u);
    return b;
}
__device__ __forceinline__ void xcd_barrier_complete(unsigned* bar, unsigned x, unsigned& nloc, unsigned& nx) {
    const unsigned G = gridDim.x * gridDim.y * gridDim.z;
    unsigned sum, cnt, mine, sp = 0u;
    for (;;) {
        sum = 0u; cnt = 0u; mine = 0u;
#pragma unroll
        for (unsigned j = 0; j < 16; ++j) { const unsigned c = xb_ld(&bar[XB_XCNT(j)]); sum += c; cnt += (c > 0u) ? 1u : 0u; mine = (j == x) ? c : mine; }
        if (sum == G) break;
        __builtin_amdgcn_s_sleep(1);
        if ((++sp & 255u) == 0u) { if (xb_ld(&bar[XB_TMO])) break; if (sp > XB_SPIN_CAP) { atomicAdd(&bar[XB_TMO], 1u); break; } }
    }
    nloc = mine > 0u ? mine : 1u; nx = cnt > 0u ? cnt : 1u;
}

__device__ __forceinline__ void xcd_barrier(const XcdBarrier& b) {
    asm volatile("s_waitcnt vmcnt(0)" ::: "memory");
    __syncthreads();
    if (threadIdx.x == 0) {
        unsigned* bar = b.bar;
        __builtin_amdgcn_s_waitcnt(0);
        unsigned nloc = b.st[0], nx = b.st[1];
        if (nloc == 0u) { xcd_barrier_complete(bar, b.x, nloc, nx); b.st[0] = nloc; b.st[1] = nx; }
        const unsigned old = xb_add(&bar[XB_XSUB(b.x)], 1u);
        const unsigned gen = old / nloc;
        if (old + 1u == (gen + 1u) * nloc) {
            __builtin_amdgcn_fence(__ATOMIC_RELEASE, "agent");
            asm volatile("s_waitcnt vmcnt(0)" ::: "memory");
            const unsigned og = xb_add(&bar[XB_TOP], 1u);
            const unsigned tg = og / nx;
            if (og + 1u == (tg + 1u) * nx) xb_add(&bar[XB_TOPGEN], 1u);
            else XB_SPIN(xb_ld(&bar[XB_TOPGEN]) == tg, bar);
            __builtin_amdgcn_fence(__ATOMIC_ACQUIRE, "agent");
            xb_add(&bar[XB_XGEN(b.x)], 1u);
            asm volatile("s_waitcnt vmcnt(0)" ::: "memory");
        } else {
            XB_SPIN(xb_ld(&bar[XB_XGEN(b.x)]) == gen, bar);
            __builtin_amdgcn_fence(__ATOMIC_ACQUIRE, "agent");
            asm volatile("s_waitcnt vmcnt(0)" ::: "memory");
        }
    }
    __syncthreads();
}

constexpr int NPHASE = 7;
constexpr int LDS_BYTES = 147456;
constexpr int RING_BYTES = 131072, MISC_OFF = RING_BYTES + 320;


__global__ void __launch_bounds__(512, 2) mega(Args args) {
    extern __shared__ __attribute__((aligned(16))) unsigned char lds_raw[];
    LAS unsigned char* lds = (LAS unsigned char*)lds_raw;
    const int tid = threadIdx.x, lane = tid & 63, wave = __builtin_amdgcn_readfirstlane(tid >> 6);
    const int G = gridDim.x, bid = blockIdx.x;
    unsigned char* ws = args.ws;
    for (int u = tid; u < (LDS_BYTES - RING_BYTES) / 4; u += 512) ((LAS unsigned*)(lds + RING_BYTES))[u] = 0u;
    __syncthreads();
    const bool multi = (args.ph_hi - args.ph_lo) > 1;
    XcdBarrier bar; bar.bar = (unsigned*)(ws + WS_CTL) + CW_BAR; bar.x = 0; bar.st = nullptr;
    if (multi) bar = xcd_barrier_post((unsigned*)(ws + WS_CTL) + CW_BAR, (volatile LAS unsigned*)(lds + MISC_OFF) + 8);


    const int lo = args.ph_lo, hi = args.ph_hi;
#define IN(k) (lo <= (k) && (k) < hi)
#define SEAM(k) do { if (IN(k) && IN((k) + 1)) xcd_barrier(bar); } while (0)
#ifndef PH_MASK
#define PH_MASK 0x7f
#endif
#define PH_EN(k) ((PH_MASK >> (k)) & 1)
#ifndef WGM_IN
#define WGM_IN 4
#endif
#ifndef WGM_M1
#define WGM_M1 4
#endif
#ifndef DUP_MASK
#define DUP_MASK 0
#endif
#define RUN(k, ...) do { if (PH_EN(k) && IN(k)) { __VA_ARGS__; if ((DUP_MASK >> (k)) & 1) { xcd_barrier(bar); __VA_ARGS__; } } SEAM(k); } while (0)
    RUN(0, { unsigned* const cnt0 = (unsigned*)(ws + WS_CTL) + CW_CNT + 192; unsigned* const tmo0 = (unsigned*)(ws + WS_CTL) + CW_BAR + XB_TMO;
        ph_modvec(args, lds, tid, lane, wave, bid, G); cnt_arrive(cnt0);
        ph_prologue(args, lds, tid, lane, wave, bid, G); for (int it = bid * 8 + wave; it < 32 * 63; it += G * 8) ssm_kc_item(args, (LAS float*)(lds + wave * 16384), it, lane);
        cnt_wait(cnt0, (unsigned)G, tmo0); ph_normmod(args, lane, wave, bid, G); });
    RUN(1, { pg8::Gemm g{(const bf16*)(ws + WS_H), (const bf16*)(ws + WS_WIN), MLAT, WIN, DM, DM, DM}; pg8::SchedX S; S.so.init(MLAT, WIN, G, bid, WGM_IN); S.extra = (MCTX / 256) * 4; S.xpm0 = MLAT / 256; S.xpn0 = 4; S.xnn = 4;
        typedef pg8::EpiIn<WS_Q, WS_KC, WS_VC, WS_UH, WS_SGA, WS_SGS, WS_ROPEC, WS_ROPES> EpiInT; EpiInT E{ws, args.in[9], args.in[10]};
        pg8::gemm_phase<EpiInT, pg8::SchedX, true, true>(lds, g, S, E);
        if (G > 64 && bid >= 64) {
            const int sb = bid - 64, SG = G - 64;
            for (int it = sb; it < 256; it += SG) ssm_expand(args, lds, tid, it);
            __syncthreads();
            ph_transposes_rest(args, lds, lane, wave, sb * 8 + wave, SG * 8);
            ph_mlp_consts(args, lds, tid, lane, wave, sb, SG); } });
    RUN(2, {
        unsigned* const cnt = (unsigned*)(ws + WS_CTL) + CW_CNT; unsigned* const tmo = (unsigned*)(ws + WS_CTL) + CW_BAR + XB_TMO;
        { pg8::Gemm g{(const bf16*)(ws + WS_UH), (const bf16*)(ws + WS_BTA), 32 * NROW_G, 32 * 256, 512, 768, 512};
          pg8::SchedSsm S{160, G, bid, 0}; pg8::EpiS E{(float*)(ws + WS_S)};
          pg8::gemm_phase<pg8::EpiS, pg8::SchedSsm, true, true>(lds, g, S, E); }
        cnt_arrive(cnt + 0);
        ph_attn(args, (char*)lds_raw, bid, G, 0, 2);
        cnt_wait(cnt + 0, (unsigned)G, tmo); ph_scan(args, lane, wave, bid, G); cnt_arrive(cnt + 64);
        ph_attn(args, (char*)lds_raw, bid, G, 2, 4);
        cnt_wait(cnt + 64, (unsigned)G, tmo);
        { pg8::Gemm g{(const bf16*)(ws + WS_UH), (const bf16*)(ws + WS_BTC), 32 * NROW_G, 32 * 512, 768, 768, 768};
          pg8::SchedSsm S{256, G, bid, 1}; pg8::EpiY E{(bf16*)(ws + WS_YG), (const bf16*)(ws + WS_UH), args.in[18]};
          pg8::gemm_phase<pg8::EpiY, pg8::SchedSsm, true, true>(lds, g, S, E); }
        cnt_arrive(cnt + 128);
        ph_attn(args, (char*)lds_raw, bid, G, 4, 6);
        cnt_wait(cnt + 128, (unsigned)G, tmo);
        { pg8::Gemm g{(const bf16*)(ws + WS_YG), (const bf16*)(ws + WS_WGLU), MLAT, DSSM, DSSM, DSSM, DSSM};
          pg8::SchedX S; S.so.init(MLAT, DSSM, G, bid); S.extra = 0; S.xpm0 = 0; S.xpn0 = 0; S.xnn = 1;
          pg8::EpiF<1> E{(bf16*)args.out, ACAT_LD, args.in[20], (const bf16*)(ws + WS_YG), DSSM, nullptr};
          pg8::gemm_phase<pg8::EpiF<1>, pg8::SchedX, true, true>(lds, g, S, E); }
        ph_attn(args, (char*)lds_raw, bid, G, 6, 8); });
    RUN(3, { pg8::Gemm g{(const bf16*)args.out, (const bf16*)(ws + WS_BCAT), MLAT, DM, ACAT_LD, ACAT_LD, ACAT_LD};
        pg8::SchedX S; S.so.init(MLAT, DM, G, bid); S.extra = 0; S.xpm0 = 0; S.xpn0 = 0; S.xnn = 1;
        pg8::EpiMerge E{(bf16*)(ws + WS_MG), (const bf16*)(ws + WS_SGA), (const bf16*)(ws + WS_SGS)};
        pg8::gemm_phase<pg8::EpiMerge, pg8::SchedX, true, true, 8>(lds, g, S, E); });
    RUN(4, { pg8::Gemm g{(const bf16*)(ws + WS_MG), (const bf16*)(ws + WS_WOUT), MLAT, DM, DM, DM, DM};
        pg8::SchedX S; S.so.init(MLAT, DM, G, bid); S.extra = 0; S.xpm0 = 0; S.xpn0 = 0; S.xnn = 1;
        pg8::EpiX1 E{args.in[0], (bf16*)(ws + WS_X1), (bf16*)args.out, (const float*)(ws + WS_MV) + 2048, (const float*)(ws + WS_GM), (float*)(ws + WS_ROWSS), 6144};
        pg8::gemm_phase<pg8::EpiX1, pg8::SchedX, true, true>(lds, g, S, E); });
    RUN(5, { pg8::Gemm g{(const bf16*)args.out, (const bf16*)(ws + WS_W1), MLAT, DFF, DM, DM, DM};
        pg8::SchedX S; S.so.init(MLAT, DFF, G, bid, WGM_M1); S.extra = 0; S.xpm0 = 0; S.xpn0 = 0; S.xnn = 1;
        pg8::EpiMlp1 E{(bf16*)(ws + WS_P), (const float*)(ws + WS_ROWSS), (const float*)(ws + WS_SHB)};
        pg8::gemm_phase<pg8::EpiMlp1, pg8::SchedX, true, true>(lds, g, S, E); });
    RUN(6, { pg8::Gemm g{(const bf16*)(ws + WS_P), (const bf16*)(ws + WS_W2), MLAT, DM, DFF, DFF, DFF};
        pg8::SchedX S; S.so.init(MLAT, DM, G, bid); S.extra = 0; S.xpm0 = 0; S.xpn0 = 0; S.xnn = 1; S.rev = (G == 256) ? 2 : 0;
        pg8::EpiOut E{args.in[0], (const bf16*)(ws + WS_X1), args.out, (const float*)(ws + WS_MV) + 5120, args.in[27], 6144};
        pg8::gemm_phase<pg8::EpiOut, pg8::SchedX, true, true>(lds, g, S, E); });
#undef IN
#undef SEAM
}

#ifndef MK_SPLIT
#define MK_SPLIT 0
#endif
extern "C" void kernel_launch(void* const* d_in, const int* in_sizes, int n_in, void* d_out, int out_size, void* d_ws, size_t ws_size, hipStream_t stream) {
    static int grid = 0;
    if (grid == 0) {
        if (n_in != 28 || out_size != MLAT * DM || ws_size < WS_END) { fprintf(stderr, "kernel_launch: unexpected shapes (n_in %d out %d ws %zu)\n", n_in, out_size, ws_size); grid = -1; return; }
        int dev = 0, cus = 0, per_cu = 0;
        hipGetDevice(&dev); hipDeviceGetAttribute(&cus, hipDeviceAttributeMultiprocessorCount, dev);
        hipFuncSetAttribute((const void*)mega, hipFuncAttributeMaxDynamicSharedMemorySize, LDS_BYTES);
        hipOccupancyMaxActiveBlocksPerMultiprocessor(&per_cu, (const void*)mega, 512, LDS_BYTES);
        (void)hipGetLastError();
        if (per_cu < 1) { fprintf(stderr, "kernel_launch: occupancy query says %d blocks/CU\n", per_cu); per_cu = 1; }
        grid = cus;
        fprintf(stderr, "kernel_launch: grid %d (cus %d, per_cu %d)\n", grid, cus, per_cu);
    }
    if (grid < 0) return;
    hipMemsetAsync((char*)d_ws + WS_CTL, 0, CTL_ZERO_BYTES, stream);
    Args a{};
    for (int i = 0; i < 28; ++i) a.in[i] = (const float*)d_in[i];
    a.out = (float*)d_out; a.ws = (unsigned char*)d_ws;
#if MK_SPLIT
    for (int ph = 0; ph < NPHASE; ++ph) { a.ph_lo = ph; a.ph_hi = ph + 1; a.li = ph; hipLaunchKernelGGL(mega, dim3(grid), dim3(512), LDS_BYTES, stream, a); }
#else
    a.ph_lo = 0; a.ph_hi = NPHASE; a.li = 0;
    hipLaunchKernelGGL(mega, dim3(grid), dim3(512), LDS_BYTES, stream, a);
#endif
}
```

```cpp
#include <hip/hip_runtime.h>
#include <cstdio>
#include <cstdint>
#include <cmath>
namespace pg8 {
#define PG8_LAS __attribute__((address_space(3)))
typedef unsigned short bf16_t;
typedef short bf16x8 __attribute__((ext_vector_type(8)));
typedef float f32x4 __attribute__((ext_vector_type(4)));
typedef unsigned u32x4 __attribute__((ext_vector_type(4)));
constexpr int BM = 256, BK = 64, HALF = 128, HTB = HALF * BK * 2  , STAGE_BYTES = 8 * HTB, NXCD = 8, WGM = 8;

__host__ __device__ __forceinline__ int lds_byte(int r, int c) { const int st = (r >> 4) * 2 + (c >> 5), rr = r & 15, cc = c & 31, ob = rr * 64 + cc * 2; return st * 1024 + (ob ^ (((ob >> 9) & 1) << 5)); }
__host__ __device__ __forceinline__ void stage_rc(int b, int& R, int& C) { const int st = b / 1024, sb = b % 1024, swz = sb ^ (((sb >> 9) & 1) << 5); R = (st >> 1) * 16 + swz / 64; C = (st & 1) * 32 + (swz % 64) / 2; }
__host__ __device__ __forceinline__ int perm32(int rho) { const int n = rho >> 4, i = rho & 15; return 8 * (i >> 2) + 4 * n + (i & 3); }

struct Unit { int pm, pn; };
struct Gemm { const bf16_t* A; const bf16_t* Bt; int M, N, K, lda, ldb; };

struct StaticOrder {
    int nM, nN, nwg, G, c, wgm;
    __host__ __device__ void init(int M, int N, int G_, int c_, int wgm_ = WGM) { nM = M / BM; nN = N / BM; nwg = nM * nN; G = G_; c = c_; wgm = wgm_; }
    __host__ __device__ bool next(int i, Unit& u) const {
        const long L = (long)i * G + c; if (L >= nwg) return false;
        int wgid = (int)L; { const int q = nwg / NXCD, r = nwg % NXCD, xcd = wgid % NXCD, off = wgid / NXCD; wgid = (xcd < r ? xcd * (q + 1) : r * (q + 1) + (xcd - r) * q) + off; }
        const int nig = wgm * nN, gid = wgid / nig, fm = gid * wgm, gsz = (nM - fm) < wgm ? (nM - fm) : wgm;
        u.pm = fm + ((wgid % nig) % gsz); u.pn = (wgid % nig) / gsz; return true;
    }
    __device__ __forceinline__ void a_ready(const Unit&) const {}
    __device__ __forceinline__ void done(const Unit&) const {}
};

__device__ __forceinline__ unsigned cvt_pk_bf16(float lo, float hi) { unsigned r; asm volatile("v_cvt_pk_bf16_f32 %0, %1, %2" : "=v"(r) : "v"(lo), "v"(hi)); return r; }
typedef float f32x2 __attribute__((ext_vector_type(2)));
__device__ __forceinline__ f32x2 gelu_pk(f32x2 v) {
    const f32x2 av = __builtin_elementwise_abs(v), d = av * 0.2316418882f + 1.0f;
    f32x2 t; t.x = __builtin_amdgcn_rcpf(d.x); t.y = __builtin_amdgcn_rcpf(d.y);
    f32x2 q = t * 0.5307027145f + (-0.7265760135f); q = q * t + 0.7107068705f; q = q * t + (-0.142248368f); q = q * t + 0.127414796f; q = q * t;
    const f32x2 s = (v * v) * (-0.72134752044f);
    f32x2 e; e.x = __builtin_amdgcn_exp2f(s.x); e.y = __builtin_amdgcn_exp2f(s.y);
    const f32x2 m = v * (q * e), r = v - m;
    f32x2 o; o.x = v.x < 0.f ? m.x : r.x; o.y = v.y < 0.f ? m.y : r.y; return o;
}

template <int ACT  > struct EpiBf16 {
    static constexpr bool PERM = true, AFTER_DRAIN = false; static_assert(ACT == 0 || ACT == 1, "EpiBf16: ACT is 0 (none) or 1 (gelu_pk)");
    bf16_t* O; int ldc; const float* bias; int split_cols; size_t split_stride; float scale0;
    __device__ __forceinline__ void operator()(const f32x4 (&acc)[2][2][4][2], const Unit& u, int wr, int wc, int fr, int fq) const {
        const int row0 = u.pm * BM + wr * 64 + fr; int colt = u.pn * BM; bf16_t* base = O;
        float sc = 1.f; if (split_cols) { const int t = colt / split_cols; base += (size_t)t * split_stride; colt -= t * split_cols; if (t == 0) sc = scale0; }
        const int col0 = colt + wc * 32 + 8 * fq, bcol0 = u.pn * BM + wc * 32 + 8 * fq;
        f32x4 bv[2][2];
#pragma unroll
        for (int bj = 0; bj < 2; ++bj)
#pragma unroll
            for (int n = 0; n < 2; ++n) bv[bj][n] = bias ? *(const f32x4*)(bias + bcol0 + bj * HALF + 4 * n) : (f32x4){0.f, 0.f, 0.f, 0.f};
#pragma unroll
        for (int ai = 0; ai < 2; ++ai)
#pragma unroll
            for (int m = 0; m < 4; ++m) { bf16_t* rowp = base + (size_t)(row0 + ai * HALF + m * 16) * ldc + col0;
#pragma unroll
                for (int bj = 0; bj < 2; ++bj) { f32x4 v0 = acc[ai][bj][m][0] + bv[bj][0], v1 = acc[ai][bj][m][1] + bv[bj][1];
                    if (ACT == 1) { f32x2 a = gelu_pk((f32x2){v0[0], v0[1]}), b = gelu_pk((f32x2){v0[2], v0[3]}), c = gelu_pk((f32x2){v1[0], v1[1]}), d = gelu_pk((f32x2){v1[2], v1[3]});
                        v0 = (f32x4){a.x, a.y, b.x, b.y}; v1 = (f32x4){c.x, c.y, d.x, d.y}; }
                    v0 = v0 * sc; v1 = v1 * sc; u32x4 w; w.x = cvt_pk_bf16(v0[0], v0[1]); w.y = cvt_pk_bf16(v0[2], v0[3]); w.z = cvt_pk_bf16(v1[0], v1[1]); w.w = cvt_pk_bf16(v1[2], v1[3]);
                    *(u32x4*)(rowp + bj * HALF) = w; } }
    }
};
template <class Epi, class Sched, bool ALIGN_EPI = false, bool SP2 = false, int HOOKT = -1>
__device__ __forceinline__ void gemm_phase(PG8_LAS unsigned char* lds, const Gemm g, const Sched& S, const Epi& E) {
    const int tid = threadIdx.x, wid = __builtin_amdgcn_readfirstlane(tid >> 6), lane = tid & 63, wr = wid >> 2, wc = wid & 3, fr = lane & 15, fq = lane >> 4;
    const int K = g.K, nt = K / BK;
    unsigned voffA[2], voffB[2];
#pragma unroll
    for (int i = 0; i < 2; ++i) { int R, C; stage_rc(tid * 16 + i * 8192, R, C); const int Rb = Epi::PERM ? ((R & ~31) + perm32(R & 31)) : R;
        voffA[i] = (unsigned)(R * g.lda + C) * 2u; voffB[i] = (unsigned)(Rb * g.ldb + C) * 2u; }
    const size_t kstep = (size_t)(BK * 2);
    const size_t hstepA = (size_t)HALF * g.lda * 2, hstepB = (size_t)HALF * g.ldb * 2;
    const size_t tstepA = 2 * hstepA, tstepB = 2 * hstepB;
    const unsigned ldsw = (unsigned)wid * 1024u;
    const int aoff = lds_byte(wr * 64 + fr, fq * 8), boff = lds_byte(wc * 32 + fr, fq * 8);
#define PG8_SA(b, h) (((b) * 2 + (h)) * HTB)
#define PG8_SB(b, h) ((4 + (b) * 2 + (h)) * HTB)
#define PG8_STAGE(bufoff, gbase, voff) do { _Pragma("unroll") for (int _i = 0; _i < 2; ++_i) \
        __builtin_amdgcn_global_load_lds((const unsigned*)((const char*)(gbase) + (voff)[_i]), (PG8_LAS unsigned*)(lds + (bufoff) + ldsw + _i * 8192), 16, 0, 0); } while (0)
#define PG8_LDA(dst, b, h) do { _Pragma("unroll") for (int m = 0; m < 4; ++m) _Pragma("unroll") for (int k = 0; k < 2; ++k) dst[m][k] = *(const PG8_LAS bf16x8*)(lds + PG8_SA(b, h) + aoff + m * 2048 + k * 1024); } while (0)
#define PG8_LDB(dst, b, h) do { _Pragma("unroll") for (int n = 0; n < 2; ++n) _Pragma("unroll") for (int k = 0; k < 2; ++k) dst[n][k] = *(const PG8_LAS bf16x8*)(lds + PG8_SB(b, h) + boff + n * 2048 + k * 1024); } while (0)
#define PG8_MMA(ai, bj, At, Bt) do { __builtin_amdgcn_s_setprio(1); _Pragma("unroll") for (int m = 0; m < 4; ++m) _Pragma("unroll") for (int n = 0; n < 2; ++n) _Pragma("unroll") for (int k = 0; k < 2; ++k) \
        acc[ai][bj][m][n] = __builtin_amdgcn_mfma_f32_16x16x32_bf16(Bt[n][k], At[m][k], acc[ai][bj][m][n], 0, 0, 0); __builtin_amdgcn_s_setprio(0); } while (0)
#define PG8_WAIT_V(n) asm volatile("s_waitcnt vmcnt(" #n ")" ::: "memory")
#define PG8_WAIT_L(n) asm volatile("s_waitcnt lgkmcnt(" #n ")" ::: "memory")
#define PG8_BAR __builtin_amdgcn_s_barrier()
#define PG8_SCHED __builtin_amdgcn_sched_barrier(0)
    Unit cur, nxt; int ui = 0;
    if (!S.next(0, cur)) return;
    f32x4 acc[2][2][4][2];
#pragma unroll
    for (int a = 0; a < 2; ++a)
#pragma unroll
        for (int b = 0; b < 2; ++b)
#pragma unroll
            for (int m = 0; m < 4; ++m)
#pragma unroll
                for (int n = 0; n < 2; ++n) acc[a][b][m][n] = (f32x4){0.f, 0.f, 0.f, 0.f};
    bf16x8 At[4][2], B0[2][2], B1[2][2];
    const char* cA = (const char*)g.A + (size_t)cur.pm * tstepA; const char* cB = (const char*)g.Bt + (size_t)cur.pn * tstepB;
    S.a_ready(cur);
    if constexpr (SP2) {
        PG8_STAGE(PG8_SB(0, 0), cB, voffB); PG8_STAGE(PG8_SB(0, 1), cB + hstepB, voffB); PG8_STAGE(PG8_SA(0, 0), cA, voffA); PG8_STAGE(PG8_SA(0, 1), cA + hstepA, voffA);
        if (wr == 1) PG8_BAR;
        PG8_WAIT_V(2); PG8_BAR;
        PG8_STAGE(PG8_SB(1, 0), cB + kstep, voffB); PG8_STAGE(PG8_SA(1, 0), cA + kstep, voffA); PG8_STAGE(PG8_SB(1, 1), cB + hstepB + kstep, voffB);
        PG8_WAIT_V(6); PG8_BAR;
    } else {
        PG8_STAGE(PG8_SB(0, 0), cB, voffB); PG8_STAGE(PG8_SA(0, 0), cA, voffA); PG8_STAGE(PG8_SB(0, 1), cB + hstepB, voffB); PG8_STAGE(PG8_SA(0, 1), cA + hstepA, voffA);
        if (wr == 1) PG8_BAR;
        PG8_WAIT_V(4); PG8_BAR;
        PG8_STAGE(PG8_SB(1, 0), cB + kstep, voffB); PG8_STAGE(PG8_SA(1, 0), cA + kstep, voffA); PG8_STAGE(PG8_SB(1, 1), cB + hstepB + kstep, voffB);
        PG8_WAIT_V(6); PG8_BAR;
    }
    for (;;) {
        const bool has_next = S.next(ui + 1, nxt);
        const char* nA = has_next ? (const char*)g.A + (size_t)nxt.pm * tstepA : cA; const char* nB = has_next ? (const char*)g.Bt + (size_t)nxt.pn * tstepB : cB;
        for (int tseg = 0; tseg < nt; ) { const int tend = (HOOKT >= 0 && tseg < HOOKT) ? HOOKT : nt;
#pragma nounroll
        for (int t = tseg; t < tend; t += 2) {
            const bool last = (t == nt - 2);
            const char* a1 = cA + (size_t)(t + 1) * kstep;
            const char* a2 = last ? nA : cA + (size_t)(t + 2) * kstep; const char* b2 = last ? nB : cB + (size_t)(t + 2) * kstep;
            const char* a3 = a2 + kstep; const char* b3 = b2 + kstep;
            if (last && has_next) S.a_ready(nxt);
            if constexpr (SP2) {
            PG8_LDB(B0, 0, 0); PG8_LDB(B1, 0, 1); PG8_SCHED; PG8_LDA(At, 0, 0); PG8_STAGE(PG8_SA(1, 1), a1 + hstepA, voffA);
            PG8_WAIT_V(8); PG8_WAIT_L(0); PG8_BAR; PG8_MMA(0, 0, At, B0); PG8_MMA(0, 1, At, B1); PG8_BAR; PG8_SCHED;
            PG8_LDA(At, 0, 1); PG8_STAGE(PG8_SB(0, 0), b2, voffB); PG8_STAGE(PG8_SB(0, 1), b2 + hstepB, voffB); PG8_STAGE(PG8_SA(0, 0), a2, voffA);
            PG8_WAIT_V(8); PG8_WAIT_L(0); PG8_BAR; PG8_MMA(1, 0, At, B0); PG8_MMA(1, 1, At, B1); PG8_BAR; PG8_SCHED;
            PG8_LDB(B0, 1, 0); PG8_LDB(B1, 1, 1); PG8_SCHED; PG8_LDA(At, 1, 0); PG8_STAGE(PG8_SA(0, 1), a2 + hstepA, voffA);
            PG8_WAIT_V(8); PG8_WAIT_L(0); PG8_BAR; PG8_MMA(0, 0, At, B0); PG8_MMA(0, 1, At, B1); PG8_BAR; PG8_SCHED;
            PG8_LDA(At, 1, 1); PG8_STAGE(PG8_SB(1, 0), b3, voffB); PG8_STAGE(PG8_SB(1, 1), b3 + hstepB, voffB); PG8_STAGE(PG8_SA(1, 0), a3, voffA);
            PG8_WAIT_V(8); PG8_WAIT_L(0); PG8_BAR; PG8_MMA(1, 0, At, B0); PG8_MMA(1, 1, At, B1); PG8_BAR; PG8_SCHED;
            } else {
            PG8_LDB(B0, 0, 0); PG8_SCHED; PG8_LDA(At, 0, 0); PG8_STAGE(PG8_SA(1, 1), a1 + hstepA, voffA);
            PG8_WAIT_L(8); PG8_BAR; PG8_WAIT_L(0); PG8_MMA(0, 0, At, B0); PG8_BAR; PG8_SCHED;
            PG8_LDB(B1, 0, 1); PG8_STAGE(PG8_SB(0, 0), b2, voffB);
            PG8_BAR; PG8_WAIT_L(0); PG8_MMA(0, 1, At, B1); PG8_BAR;
            PG8_LDA(At, 0, 1); PG8_STAGE(PG8_SA(0, 0), a2, voffA);
            PG8_BAR; PG8_WAIT_L(0); PG8_MMA(1, 0, At, B0); PG8_BAR; PG8_SCHED;
            PG8_STAGE(PG8_SB(0, 1), b2 + hstepB, voffB);
            PG8_WAIT_V(6); PG8_BAR; PG8_MMA(1, 1, At, B1); PG8_BAR;
            PG8_LDB(B0, 1, 0); PG8_SCHED; PG8_LDA(At, 1, 0); PG8_STAGE(PG8_SA(0, 1), a2 + hstepA, voffA);
            PG8_WAIT_L(8); PG8_BAR; PG8_WAIT_L(0); PG8_MMA(0, 0, At, B0); PG8_BAR; PG8_SCHED;
            PG8_LDB(B1, 1, 1); PG8_STAGE(PG8_SB(1, 0), b3, voffB);
            PG8_BAR; PG8_WAIT_L(0); PG8_MMA(0, 1, At, B1); PG8_BAR;
            PG8_LDA(At, 1, 1); PG8_STAGE(PG8_SA(1, 0), a3, voffA);
            PG8_BAR; PG8_WAIT_L(0); PG8_MMA(1, 0, At, B0); PG8_BAR; PG8_SCHED;
            PG8_STAGE(PG8_SB(1, 1), b3 + hstepB, voffB);
            PG8_WAIT_V(6); PG8_BAR; PG8_MMA(1, 1, At, B1); PG8_BAR;
            }
        }
        if constexpr (HOOKT >= 0) { if (tend != nt) E.mid(acc, cur, wr, wc, fr, fq); }
        tseg = tend; }
        if constexpr (ALIGN_EPI) { if (wr == 0) PG8_BAR; }
        if constexpr (!Epi::AFTER_DRAIN) { E(acc, cur, wr, wc, fr, fq); S.done(cur); }
        if (!has_next) break;
#pragma unroll
        for (int a = 0; a < 2; ++a)
#pragma unroll
            for (int b = 0; b < 2; ++b)
#pragma unroll
                for (int m = 0; m < 4; ++m)
#pragma unroll
                    for (int n = 0; n < 2; ++n) acc[a][b][m][n] = (f32x4){0.f, 0.f, 0.f, 0.f};
        cur = nxt; cA = nA; cB = nB; ++ui;
        if constexpr (ALIGN_EPI) { if (wr == 1) PG8_BAR; }
    }
    PG8_WAIT_V(0);
    if constexpr (!ALIGN_EPI) { if (wr == 0) PG8_BAR; }
    PG8_BAR;
    if constexpr (Epi::AFTER_DRAIN) { E.fused(acc, cur, wr, wc, fr, fq, lds, wid, lane); S.done(cur); }
#undef PG8_SA
#undef PG8_SB
#undef PG8_STAGE
#undef PG8_LDA
#undef PG8_LDB
#undef PG8_MMA
#undef PG8_WAIT_V
#undef PG8_WAIT_L
#undef PG8_BAR
#undef PG8_SCHED
}
}
#include <hip/hip_bf16.h>
#include <cmath>
namespace attn_body {
using bf16=__hip_bfloat16;
using bf16x8=__attribute__((ext_vector_type(8)))short;
using s16x4=__attribute__((ext_vector_type(4)))short;
using f32x16=__attribute__((ext_vector_type(16)))float;
using u32x4=__attribute__((ext_vector_type(4)))unsigned;
constexpr int NHEAD=16,SEQ=2048,D=64;
constexpr int NKT=36, NKT_LAT=32;
constexpr int NW=8,QBLK=32,QB=QBLK*NW,KVBLK=64,NQB=SEQ/QB;
constexpr int ATTN_UNIT_ROWS=QB;
__device__ __forceinline__ int crow(int r,int hi){return (r&3)+8*(r>>2)+4*hi;}
#define SBAR() __builtin_amdgcn_sched_barrier(0)
__device__ __forceinline__ void cmask(f32x16&p0,f32x16&p1,int jb,int qrel,int hi){
  const float NEG=-INFINITY; int kb=64*jb+4*hi;
  #pragma unroll
  for(int r=0;r<16;++r){int kv=kb+(r&3)+8*(r>>2); if(kv>qrel)p0[r]=NEG; if(kv+32>qrel)p1[r]=NEG;}
}

constexpr int NSLOT=3, SLOTB=8192;
constexpr int LDS_K=0, LDS_V=NSLOT*SLOTB, LDS_WS=2*NSLOT*SLOTB, LDS_OST=LDS_WS+NW*64*4, LDS_BYTES=LDS_OST+NW*4096;
constexpr float C2=0.125f*1.4426950408889634f;
__device__ __forceinline__ void glds16(const void*gsrc,unsigned lds_dst){unsigned keep;
  asm volatile("s_mov_b32 %0, m0\n\ts_mov_b32 m0, %2\n\ts_nop 0\n\tglobal_load_lds_dwordx4 %1, off\n\ts_mov_b32 m0, %0":"=&s"(keep):"v"(gsrc),"s"(lds_dst):"memory");}
__device__ __forceinline__ float max3f(float a,float b,float c){float r;asm("v_max3_f32 %0, %1, %2, %3":"=v"(r):"v"(a),"v"(b),"v"(c));return r;}
__device__ __forceinline__ float max2f(float a,float b){float r;asm("v_max_f32_e32 %0, %1, %2":"=v"(r):"v"(a),"v"(b));return r;}
__device__ __forceinline__ float fadd_s(float a,float b){float r;asm("v_add_f32_e32 %0, %1, %2":"=v"(r):"v"(a),"v"(b));return r;}
__device__ __forceinline__ float fsub_s(float a,float b){float r;asm("v_sub_f32_e32 %0, %1, %2":"=v"(r):"v"(a),"v"(b));return r;}
typedef float f32x2_t __attribute__((ext_vector_type(2))); typedef __bf16 bf16x2_t __attribute__((ext_vector_type(2)));
__device__ __forceinline__ unsigned cvtpk_s(float lo,float hi){f32x2_t v={lo,hi};bf16x2_t b=__builtin_convertvector(v,bf16x2_t);return __builtin_bit_cast(unsigned,b);}
#define WAIT_BAR(N) asm volatile("s_waitcnt vmcnt(" #N ") lgkmcnt(0)\n\ts_barrier":::"memory")

__device__ __forceinline__ void qkt(f32x16&p0,f32x16&p1,const char*Kslot,const bf16x8*qr,const f32x16&negm,int r32,int hi){
  const char*kb=Kslot+hi*1024+r32*16;
  #pragma unroll
  for(int d0=0;d0<4;++d0){
    const bf16x8 b0=*reinterpret_cast<const bf16x8*>(kb+d0*2048);
    const bf16x8 b1=*reinterpret_cast<const bf16x8*>(kb+d0*2048+512);
    if(d0==0){p0=__builtin_amdgcn_mfma_f32_32x32x16_bf16(b0,qr[0],negm,0,0,0);p1=__builtin_amdgcn_mfma_f32_32x32x16_bf16(b1,qr[0],negm,0,0,0);}
    else{p0=__builtin_amdgcn_mfma_f32_32x32x16_bf16(b0,qr[d0],p0,0,0,0);p1=__builtin_amdgcn_mfma_f32_32x32x16_bf16(b1,qr[d0],p1,0,0,0);}}
}
typedef __attribute__((address_space(3))) const char* lds_cptr;
typedef short v4i16_t __attribute__((ext_vector_type(4)));
__device__ __forceinline__ void kload8(bf16x8*kf,lds_cptr kp){
  kf[0]=*(const __attribute__((address_space(3))) bf16x8*)(kp);      kf[1]=*(const __attribute__((address_space(3))) bf16x8*)(kp+512);
  kf[2]=*(const __attribute__((address_space(3))) bf16x8*)(kp+2048); kf[3]=*(const __attribute__((address_space(3))) bf16x8*)(kp+2560);
  kf[4]=*(const __attribute__((address_space(3))) bf16x8*)(kp+4096); kf[5]=*(const __attribute__((address_space(3))) bf16x8*)(kp+4608);
  kf[6]=*(const __attribute__((address_space(3))) bf16x8*)(kp+6144); kf[7]=*(const __attribute__((address_space(3))) bf16x8*)(kp+6656);
}
__device__ __forceinline__ void kload2(bf16x8*kf,lds_cptr kp,int j){ kf[2*j]=*(const __attribute__((address_space(3))) bf16x8*)(kp+j*2048); kf[2*j+1]=*(const __attribute__((address_space(3))) bf16x8*)(kp+j*2048+512); }
__device__ __forceinline__ s16x4 vtr(lds_cptr p){ return __builtin_bit_cast(s16x4,__builtin_amdgcn_ds_read_tr16_b64_v4i16((__attribute__((address_space(3))) v4i16_t*)p)); }
__device__ __forceinline__ float rowmax(const f32x16&p0,const f32x16&p1){
  float a=max3f(p0[0],p0[1],p1[0]),b=max3f(p0[2],p0[3],p1[1]);a=max3f(a,p1[2],p1[3]);
  #pragma unroll
  for(int r=4;r<16;r+=4){a=max3f(a,p0[r],p0[r+1]);b=max3f(b,p0[r+2],p0[r+3]);a=max3f(a,p1[r],p1[r+1]);b=max3f(b,p1[r+2],p1[r+3]);}
  const float m=max2f(a,b);
  auto rr=__builtin_amdgcn_permlane32_swap(__float_as_uint(m),__float_as_uint(m),false,false);
  return max2f(__uint_as_float(rr[0]),__uint_as_float(rr[1]));
}
__device__ __forceinline__ void pv(f32x16*o,int vb,bf16x8 pa0,bf16x8 pa1,bf16x8 pa2,bf16x8 pa3){
  #pragma unroll
  for(int d0=0;d0<2;++d0){s16x4 lo[4],hi[4];
    #pragma unroll
    for(int ks=0;ks<4;++ks){
      asm volatile("ds_read_b64_tr_b16 %0,%1 offset:%c2":"=&v"(lo[ks]):"v"(vb),"i"(d0*4096+ks*1024):"memory");
      asm volatile("ds_read_b64_tr_b16 %0,%1 offset:%c2":"=&v"(hi[ks]):"v"(vb),"i"(d0*4096+ks*1024+512):"memory");}
    asm volatile("s_waitcnt lgkmcnt(0)":::"memory");SBAR();
    #define PK(k) (bf16x8){lo[k][0],lo[k][1],lo[k][2],lo[k][3],hi[k][0],hi[k][1],hi[k][2],hi[k][3]}
    o[d0]=__builtin_amdgcn_mfma_f32_32x32x16_bf16(pa0,PK(0),o[d0],0,0,0);
    o[d0]=__builtin_amdgcn_mfma_f32_32x32x16_bf16(pa1,PK(1),o[d0],0,0,0);
    o[d0]=__builtin_amdgcn_mfma_f32_32x32x16_bf16(pa2,PK(2),o[d0],0,0,0);
    o[d0]=__builtin_amdgcn_mfma_f32_32x32x16_bf16(pa3,PK(3),o[d0],0,0,0);
    #undef PK
  }
}

#ifndef ATTN_STORE16
#define ATTN_STORE16(p,v) (*(u32x4*)(p)=(v))
#endif
template<int THRL,int QP,int KVP,int OP> __device__ __forceinline__ void attn_unit(int h,int qb,const bf16*Qb,const bf16*Kl,const bf16*Vl,const bf16*Kc,const bf16*Vc,bf16*Ob,char*shm){
  int tid=threadIdx.x; asm volatile("":"+v"(tid));
  const int lane=tid&63,r32=lane&31,hi=lane>>5; const int wid=__builtin_amdgcn_readfirstlane(tid>>6);
  const int q0=qb*QB;
  const bf16*Qw=Qb+(long)(q0+wid*QBLK)*QP+h*D;
  const int kvh=h>>2; const bf16*Kh=Kl+kvh*D,*Vh=Vl+kvh*D; const long cdk=(Kc-Kl)-(long)NKT_LAT*KVBLK*KVP, cdv=(Vc-Vl)-(long)NKT_LAT*KVBLK*KVP;
  const unsigned lds0=(unsigned)(uintptr_t)shm;
  float*wsf=(float*)(shm+LDS_WS)+wid*64;
  const bf16*ksrc=Kh+(long)lane*KVP+wid*8;
  const bf16*vsrc=Vh+(long)(16*(wid&3)+(lane>>2))*KVP+(wid>>2)*32+(lane&3)*8;
  const unsigned kdst=lds0+LDS_K+wid*1024, vdst=lds0+LDS_V+wid*1024;
  #define DMA_K(t,slot) glds16(ksrc+(long)(t)*KVBLK*KVP+(((t)>=NKT_LAT)?cdk:0l),(unsigned)__builtin_amdgcn_readfirstlane(kdst+(slot)))
  #define DMA_V(t,slot) glds16(vsrc+(long)(t)*KVBLK*KVP+(((t)>=NKT_LAT)?cdv:0l),(unsigned)__builtin_amdgcn_readfirstlane(vdst+(slot)))
  const int vb0=(int)(lds0+LDS_V)+((lane>>4)&1)*32+(lane&3)*8+(4*hi+((lane&15)>>2))*64;
  const char*Kbase=shm+LDS_K; bf16x8 kf[8];
  const lds_cptr shm3=(lds_cptr)shm; const lds_cptr kp0=shm3+LDS_K+hi*1024+r32*16; const lds_cptr vp0=shm3+LDS_V+((lane>>4)&1)*32+(lane&3)*8+(4*hi+((lane&15)>>2))*64;
  constexpr int NT=NKT;
  DMA_K(0,0);DMA_V(0,0);DMA_K(1,SLOTB);
  bf16x8 qr[4];
  #pragma unroll
  for(int d0=0;d0<4;++d0)qr[d0]=*reinterpret_cast<const bf16x8*>(&Qw[(long)r32*QP+d0*16+hi*8]);
  float mhat=0.f,l_reg=0.f;f32x16 o[2];o[0]=f32x16{};o[1]=f32x16{};f32x16 negm=f32x16{};asm volatile("":"+v"(negm));
  #define CMASK(P0,P1,t) do{}while(0)
  bool resc=false;
  #define START(P0,P1) do{ const float rm=rowmax(P0,P1); resc=false; \
    { const float dl=rm; mhat=fadd_s(mhat,dl); \
      _Pragma("unroll") for(int r=0;r<16;++r){P0[r]=fsub_s(P0[r],dl);P1[r]=fsub_s(P1[r],dl);} \
      _Pragma("unroll") for(int r=0;r<16;++r)negm[r]=-mhat; asm volatile("":"+v"(negm)); } \
    _Pragma("unroll") for(int r=0;r<16;++r)P0[r]=__builtin_amdgcn_exp2f(P0[r]); }while(0)
  #define RESC() do{ if(resc){ asm volatile("s_waitcnt lgkmcnt(0)":::"memory"); \
      _Pragma("unroll") for(int d_=0;d_<2;++d_) _Pragma("unroll") for(int r=0;r<16;++r)o[d_][r]*=wsf[crow(r,hi)]; } }while(0)
  f32x16 pA0,pA1,pB0,pB1;
  int sl_prev=0,sl_cur=0,sl_next=SLOTB;
  #define ROT() do{sl_prev=sl_cur;sl_cur=sl_next;sl_next=(sl_next==(NSLOT-1)*SLOTB)?0:sl_next+SLOTB;}while(0)
  DMA_K(2,2*SLOTB);
  WAIT_BAR(3);
  qkt(pA0,pA1,Kbase,qr,negm,r32,hi);asm volatile("s_nop 15\n\ts_nop 7":"+v"(pA0),"+v"(pA1));CMASK(pA0,pA1,0);
  START(pA0,pA1);
  _Pragma("unroll") for(int r=0;r<16;++r)pA1[r]=__builtin_amdgcn_exp2f(pA1[r]);
  WAIT_BAR(0);
  DMA_K(3,0);DMA_V(1,SLOTB);
  ROT();
  kload8(kf,kp0+sl_cur);
  WAIT_BAR(2);
  s16x4 vlo[8],vhi[8]; u32x4 pw0,pw1,pw2,pw3;
  #define PKW(P,B) cvtpk_s(P[B],P[B+1])
  #define PAF(k) __builtin_bit_cast(bf16x8,pw##k)
  #define VFR(i) (bf16x8){vlo[i][0],vlo[i][1],vlo[i][2],vlo[i][3],vhi[i][0],vhi[i][1],vhi[i][2],vhi[i][3]}
  #define PIN(x) asm volatile("":"+v"(x))
  #define MX3(a,b,c) __builtin_fmaxf(__builtin_fmaxf((a),(b)),(c))
  #define GAPA(MF,A0,A1,A2,A3,W0,W1,PW) do{ MF; sacc+=A0; sacc+=A1; sacc+=A2; sacc+=A3; PIN(sacc); W0; W1; PIN(PW); SBAR(); }while(0)
  #define EX(v) __builtin_amdgcn_exp2f(v)
  #define GAPB(MF,X,B) do{ MF; X[B]=EX(X[B]); X[B+1]=EX(X[B+1]); X[B+2]=EX(X[B+2]); X[B+3]=EX(X[B+3]); PIN(X); SBAR(); }while(0)
  #define VRD(i) do{ vlo[i]=vtr(vp_+(((i)>>2)*4096+((i)&3)*1024)); vhi[i]=vtr(vp_+(((i)>>2)*4096+((i)&3)*1024+512)); }while(0)
  #define KRD(G,j) do{ if(G){ kload2(kf,kp0+sl_next,j); SBAR(); } }while(0)
  #define STEP(C0,C1,P0,P1,t,GK,GV,GL) do{ SBAR(); \
    const lds_cptr vp_=vp0+sl_prev; \
    VRD(0); SBAR(); float sacc=(P0[0]+P0[1]); \
    GAPA(C0=__builtin_amdgcn_mfma_f32_32x32x16_bf16(kf[0],qr[0],negm,0,0,0), P0[2],P0[3],P0[4],P0[5],     pw0[0]=PKW(P0,0), pw0[1]=PKW(P0,2), pw0); \
    VRD(4); SBAR(); GAPA(C1=__builtin_amdgcn_mfma_f32_32x32x16_bf16(kf[1],qr[0],negm,0,0,0), P0[6],P0[7],P0[8],P0[9],     pw0[2]=PKW(P0,4), pw0[3]=PKW(P0,6), pw0); \
    VRD(1); SBAR(); GAPA(C0=__builtin_amdgcn_mfma_f32_32x32x16_bf16(kf[2],qr[1],C0,0,0,0),   P0[10],P0[11],P0[12],P0[13], pw1[0]=PKW(P0,8), pw1[1]=PKW(P0,10), pw1); \
    VRD(5); SBAR(); GAPA(C1=__builtin_amdgcn_mfma_f32_32x32x16_bf16(kf[3],qr[1],C1,0,0,0),   P0[14],P0[15],P1[0],P1[1],   pw1[2]=PKW(P0,12),pw1[3]=PKW(P0,14), pw1); \
    VRD(2); SBAR(); GAPA(C0=__builtin_amdgcn_mfma_f32_32x32x16_bf16(kf[4],qr[2],C0,0,0,0),   P1[2],P1[3],P1[4],P1[5],     pw2[0]=PKW(P1,0), pw2[1]=PKW(P1,2), pw2); \
    VRD(6); SBAR(); GAPA(C1=__builtin_amdgcn_mfma_f32_32x32x16_bf16(kf[5],qr[2],C1,0,0,0),   P1[6],P1[7],P1[8],P1[9],     pw2[2]=PKW(P1,4), pw2[3]=PKW(P1,6), pw2); \
    VRD(3); SBAR(); GAPA(C0=__builtin_amdgcn_mfma_f32_32x32x16_bf16(kf[6],qr[3],C0,0,0,0),   P1[10],P1[11],P1[12],P1[13], pw3[0]=PKW(P1,8), pw3[1]=PKW(P1,10), pw3); \
    VRD(7); SBAR(); GAPA(C1=__builtin_amdgcn_mfma_f32_32x32x16_bf16(kf[7],qr[3],C1,0,0,0),   P1[14],P1[15],0.f,0.f,       pw3[2]=PKW(P1,12),pw3[3]=PKW(P1,14), pw3); \
    l_reg+=sacc; \
    if(GK){DMA_K((t)+3,sl_cur);} if(GV){DMA_V((t)+1,sl_next);} \
    CMASK(C0,C1,t); \
    { float a=MX3(C0[0],C0[1],C1[0]),b=MX3(C0[2],C0[3],C1[1]); a=MX3(a,C1[2],C1[3]); \
      _Pragma("unroll") for(int r=4;r<16;r+=4){a=MX3(a,C0[r],C0[r+1]);b=MX3(b,C0[r+2],C0[r+3]);a=MX3(a,C1[r],C1[r+1]);b=MX3(b,C1[r+2],C1[r+3]);} \
      float rm=__builtin_fmaxf(a,b); { auto rr=__builtin_amdgcn_permlane32_swap(__float_as_uint(rm),__float_as_uint(rm),false,false); rm=__builtin_fmaxf(__uint_as_float(rr[0]),__uint_as_float(rr[1])); } \
      resc=false; \
      if(__builtin_expect(__any(rm>(float)THRL),0)){ const float dl=__builtin_fmaxf(rm,0.f); mhat+=dl; \
        _Pragma("unroll") for(int r=0;r<16;++r){C0[r]-=dl;C1[r]-=dl;} \
        _Pragma("unroll") for(int r=0;r<16;++r)negm[r]=-mhat; asm volatile("":"+v"(negm)); \
        const float f=__builtin_amdgcn_exp2f(-dl); l_reg*=f; if(hi==0)wsf[r32]=f; resc=true; } } \
    SBAR(); \
    GAPB(o[0]=__builtin_amdgcn_mfma_f32_32x32x16_bf16(PAF(0),VFR(0),o[0],0,0,0), C0,0); \
    GAPB(o[1]=__builtin_amdgcn_mfma_f32_32x32x16_bf16(PAF(0),VFR(4),o[1],0,0,0), C0,4); \
    KRD(GL,0); GAPB(o[0]=__builtin_amdgcn_mfma_f32_32x32x16_bf16(PAF(1),VFR(1),o[0],0,0,0), C0,8); \
    KRD(GL,1); GAPB(o[1]=__builtin_amdgcn_mfma_f32_32x32x16_bf16(PAF(1),VFR(5),o[1],0,0,0), C0,12); \
    KRD(GL,2); GAPB(o[0]=__builtin_amdgcn_mfma_f32_32x32x16_bf16(PAF(2),VFR(2),o[0],0,0,0), C1,0); \
    KRD(GL,3); GAPB(o[1]=__builtin_amdgcn_mfma_f32_32x32x16_bf16(PAF(2),VFR(6),o[1],0,0,0), C1,4); \
    GAPB(o[0]=__builtin_amdgcn_mfma_f32_32x32x16_bf16(PAF(3),VFR(3),o[0],0,0,0), C1,8); \
    GAPB(o[1]=__builtin_amdgcn_mfma_f32_32x32x16_bf16(PAF(3),VFR(7),o[1],0,0,0), C1,12); \
    }while(0)
  int t=1;
  #undef CMASK
  #define CMASK(P0,P1,t) do{}while(0)
  for(;t+5<NT;t+=2){
    STEP(pB0,pB1,pA0,pA1,t,true,true,true);     WAIT_BAR(2); RESC(); ROT();
    STEP(pA0,pA1,pB0,pB1,t+1,true,true,true);   WAIT_BAR(2); RESC(); ROT();
  }
  #undef CMASK
  #define CMASK(P0,P1,t) do{}while(0)
  #define ENDW(tt) do{ if((tt)+3<NT){WAIT_BAR(2);} else if((tt)+2<NT){WAIT_BAR(1);} else {WAIT_BAR(0);} }while(0)
  for(;t+1<NT;t+=2){
    STEP(pB0,pB1,pA0,pA1,t,(t+3<NT),(t+1<NT),(t+1<NT));       ENDW(t);   RESC(); ROT();
    STEP(pA0,pA1,pB0,pB1,t+1,(t+4<NT),(t+2<NT),(t+2<NT));     ENDW(t+1); RESC(); ROT();
  }
  STEP(pB0,pB1,pA0,pA1,NT-1,false,false,false); RESC();
  { float sacc=pB0[0]+pB0[1]; _Pragma("unroll") for(int r=2;r<16;++r)sacc+=pB0[r]; _Pragma("unroll") for(int r=0;r<16;++r)sacc+=pB1[r]; l_reg+=sacc;
    pw0=(u32x4){PKW(pB0,0),PKW(pB0,2),PKW(pB0,4),PKW(pB0,6)};pw1=(u32x4){PKW(pB0,8),PKW(pB0,10),PKW(pB0,12),PKW(pB0,14)};pw2=(u32x4){PKW(pB1,0),PKW(pB1,2),PKW(pB1,4),PKW(pB1,6)};pw3=(u32x4){PKW(pB1,8),PKW(pB1,10),PKW(pB1,12),PKW(pB1,14)};
    SBAR(); pv(o,vb0+sl_cur,PAF(0),PAF(1),PAF(2),PAF(3)); }
  #undef PKW
  #undef PAF
  #undef VFR
  #undef PIN
  #undef MX3
  #undef GAPA
  #undef GAPB
  #undef EX
  #undef VRD
  #undef KRD
  #undef STEP
  #undef ENDW
  {auto rr=__builtin_amdgcn_permlane32_swap(__float_as_uint(l_reg),__float_as_uint(l_reg),false,false);l_reg=__uint_as_float(rr[0])+__uint_as_float(rr[1]);}
  if(hi==0)wsf[32+r32]=l_reg;asm volatile("s_waitcnt lgkmcnt(0)":::"memory");
  float rli[16];
  #pragma unroll
  for(int r=0;r<16;++r)rli[r]=__builtin_amdgcn_rcpf(wsf[32+crow(r,hi)]);
  bf16*Ow=Ob+(long)(q0+wid*QBLK)*OP+h*D;
  { bf16*stg=(bf16*)(shm+LDS_OST)+wid*2048;
    #pragma unroll
    for(int r=0;r<16;++r){const int orow=crow(r,hi);
      #pragma unroll
      for(int d0=0;d0<2;++d0)stg[orow*64+d0*32+r32]=__float2bfloat16(o[d0][r]*rli[r]);}
    asm volatile("s_waitcnt lgkmcnt(0)":::"memory");
    #pragma unroll
    for(int i=0;i<4;++i){const int row=i*8+(lane>>3),ch=lane&7; const u32x4 v=*(const u32x4*)(stg+row*64+ch*8); ATTN_STORE16(Ow+(long)row*OP+ch*8,v);} }
  asm volatile("s_waitcnt lgkmcnt(0)\n\ts_barrier":::"memory");
  #undef DMA_K
  #undef DMA_V
  #undef CMASK
  #undef START
  #undef RESC
  #undef ROT
}
constexpr int ATTN_LDS_BYTES=LDS_BYTES;
#undef SBAR
#undef WAIT_BAR
}

namespace pg8 {
struct SchedX {
    StaticOrder so; int extra, xpm0, xpn0, xnn; int rev = 0;
    __device__ bool next(int i, Unit& u) const {
        if (rev) { if (i >= rev) return false; return so.next(rev - 1 - i, u); }
        const long L = (long)i * so.G + so.c;
        if (L < so.nwg) return so.next(i, u);
        const int r = (int)(L - so.nwg); if (r >= extra) return false;
        u.pm = xpm0 + r / xnn; u.pn = xpn0 + r % xnn; return true;
    }
    __device__ __forceinline__ void a_ready(const Unit&) const {}
    __device__ __forceinline__ void done(const Unit&) const {}
};

struct SchedSsm {
    int total, G, c, mode;
    __device__ bool next(int i, Unit& u) const {
        const int L = i * G + c; if (L >= total) return false;
        if (mode == 0) { const int g = L / 5; u.pm = L; u.pn = g; }
        else { const int g = L >> 3; u.pm = g * 5 + ((L >> 1) & 3); u.pn = g * 2 + (L & 1); }
        return true;
    }
    __device__ __forceinline__ void a_ready(const Unit&) const {}
    __device__ __forceinline__ void done(const Unit&) const {}
};
struct EpiS {
    static constexpr bool PERM = true, AFTER_DRAIN = false;
    float* S;
    __device__ __forceinline__ void operator()(const f32x4 (&acc)[2][2][4][2], const Unit& u, int wr, int wc, int fr, int fq) const {
        const int row0 = u.pm * BM + wr * 64 + fr; const int col0 = wc * 32 + 8 * fq;
#pragma unroll
        for (int ai = 0; ai < 2; ++ai)
#pragma unroll
            for (int m = 0; m < 4; ++m) { float* rowp = S + (size_t)(row0 + ai * HALF + m * 16) * 256 + col0;
#pragma unroll
                for (int bj = 0; bj < 2; ++bj) { *(f32x4*)(rowp + bj * HALF) = acc[ai][bj][m][0]; *(f32x4*)(rowp + bj * HALF + 4) = acc[ai][bj][m][1]; } }
    }
};
__device__ __forceinline__ float gelu_tanh_(float x) { const float t = x * (-2.302208198f - 0.10294324f * x * x); return x * __builtin_amdgcn_rcpf(1.0f + __builtin_amdgcn_exp2f(t)); }
struct EpiY {
    static constexpr bool PERM = true, AFTER_DRAIN = false;
    bf16_t* YG; const bf16_t* UH; const float* dd;
    __device__ __forceinline__ void operator()(const f32x4 (&acc)[2][2][4][2], const Unit& u, int wr, int wc, int fr, int fq) const {
        const int g = u.pm / 5, pmq = u.pm - 5 * g, pnq = u.pn - 2 * g;
        const int h0 = 8 * (fq & 1);
        const f32x4 d0 = *(const f32x4*)(dd + g * 16 + h0), d1 = *(const f32x4*)(dd + g * 16 + h0 + 4);
#pragma unroll
        for (int ai = 0; ai < 2; ++ai)
#pragma unroll
            for (int m = 0; m < 4; ++m) { const int n = pmq * BM + ai * HALF + wr * 64 + m * 16 + fr;
#pragma unroll
                for (int bj = 0; bj < 2; ++bj) { const int t = (pnq * BM + bj * HALF + wc * 32 + 8 * fq) >> 4;
                    const u32x4 uw = *(const u32x4*)(UH + ((size_t)(g * 1280 + n)) * 768 + t * 16 + h0);
                    f32x4 v0 = acc[ai][bj][m][0], v1 = acc[ai][bj][m][1];
                    v0[0] += d0[0] * __builtin_bit_cast(float, uw.x << 16); v0[1] += d0[1] * __builtin_bit_cast(float, uw.x & 0xffff0000u);
                    v0[2] += d0[2] * __builtin_bit_cast(float, uw.y << 16); v0[3] += d0[3] * __builtin_bit_cast(float, uw.y & 0xffff0000u);
                    v1[0] += d1[0] * __builtin_bit_cast(float, uw.z << 16); v1[1] += d1[1] * __builtin_bit_cast(float, uw.z & 0xffff0000u);
                    v1[2] += d1[2] * __builtin_bit_cast(float, uw.w << 16); v1[3] += d1[3] * __builtin_bit_cast(float, uw.w & 0xffff0000u);
                    u32x4 w; w.x = cvt_pk_bf16(gelu_tanh_(v0[0]), gelu_tanh_(v0[1])); w.y = cvt_pk_bf16(gelu_tanh_(v0[2]), gelu_tanh_(v0[3]));
                    w.z = cvt_pk_bf16(gelu_tanh_(v1[0]), gelu_tanh_(v1[1])); w.w = cvt_pk_bf16(gelu_tanh_(v1[2]), gelu_tanh_(v1[3]));
                    *(u32x4*)(YG + (size_t)(n * 32 + t) * 512 + g * 16 + h0) = w; } }
    }
};

__device__ __forceinline__ float sigm_(float x) { return __builtin_amdgcn_rcpf(1.0f + __builtin_amdgcn_exp2f(-1.4426950408889634f * x)); }
__device__ __forceinline__ float bflo_(unsigned w) { return __builtin_bit_cast(float, w << 16); }
__device__ __forceinline__ float bfhi_(unsigned w) { return __builtin_bit_cast(float, w & 0xffff0000u); }
#define PG8_UNPACK8(dst0, dst1, WW) do { dst0[0] = bflo_(WW[0]); dst0[1] = bfhi_(WW[0]); dst0[2] = bflo_(WW[1]); dst0[3] = bfhi_(WW[1]); dst1[0] = bflo_(WW[2]); dst1[1] = bfhi_(WW[2]); dst1[2] = bflo_(WW[3]); dst1[3] = bfhi_(WW[3]); } while (0)
#define PG8_PACK8(WW, V0, V1) do { WW[0] = cvt_pk_bf16(V0[0], V0[1]); WW[1] = cvt_pk_bf16(V0[2], V0[3]); WW[2] = cvt_pk_bf16(V1[0], V1[1]); WW[3] = cvt_pk_bf16(V1[2], V1[3]); } while (0)
template <int MODE> struct EpiF {
    static constexpr bool PERM = true, AFTER_DRAIN = false;
    bf16_t* O; int ldc; const float* bias; const bf16_t* X; int ldx; const bf16_t* T;
    __device__ __forceinline__ void operator()(const f32x4 (&acc)[2][2][4][2], const Unit& u, int wr, int wc, int fr, int fq) const {
        const int row0 = u.pm * BM + wr * 64 + fr; const int col0 = u.pn * BM + wc * 32 + 8 * fq;
        f32x4 bv[2][2];
#pragma unroll
        for (int bj = 0; bj < 2; ++bj)
#pragma unroll
            for (int n = 0; n < 2; ++n) bv[bj][n] = (MODE == 1) ? *(const f32x4*)(bias + col0 + bj * HALF + 4 * n) : (f32x4){0.f, 0.f, 0.f, 0.f};
#pragma unroll
        for (int ai = 0; ai < 2; ++ai)
#pragma unroll
            for (int m = 0; m < 4; ++m) { const size_t row = (size_t)(row0 + ai * HALF + m * 16);
#pragma unroll
                for (int bj = 0; bj < 2; ++bj) { const int col = col0 + bj * HALF;
                    f32x4 v0 = acc[ai][bj][m][0] + bv[bj][0], v1 = acc[ai][bj][m][1] + bv[bj][1];
                    const u32x4 xw = *(const u32x4*)(X + row * ldx + col); f32x4 x0, x1; PG8_UNPACK8(x0, x1, xw);
                    if (MODE == 1) {
#pragma unroll
                        for (int e = 0; e < 4; ++e) { v0[e] = x0[e] * sigm_(v0[e]); v1[e] = x1[e] * sigm_(v1[e]); }
                    } else {
#pragma unroll
                        for (int e = 0; e < 4; ++e) { v0[e] = x0[e] * v0[e]; v1[e] = x1[e] * v1[e]; }
                        if (MODE == 3) { const u32x4 tw = *(const u32x4*)(T + row * ldc + col); f32x4 t0, t1; PG8_UNPACK8(t0, t1, tw); v0 += t0; v1 += t1; }
                    }
                    u32x4 w; PG8_PACK8(w, v0, v1); *(u32x4*)(O + row * ldc + col) = w; } }
    }
};
struct EpiX1 {
    static constexpr bool PERM = true, AFTER_DRAIN = false;
    const float* x; bf16_t* MIX; bf16_t* XG; const float* g1; const float* gm; float* rowss;
    int ldm;
    __device__ __forceinline__ void operator()(const f32x4 (&acc)[2][2][4][2], const Unit& u, int wr, int wc, int fr, int fq) const {
        const int row0 = u.pm * BM + wr * 64 + fr; const int col0 = u.pn * BM + wc * 32 + 8 * fq; const int b = u.pm >> 3;
        f32x4 gv[2][2], mv[2][2];
#pragma unroll
        for (int bj = 0; bj < 2; ++bj)
#pragma unroll
            for (int n = 0; n < 2; ++n) { gv[bj][n] = *(const f32x4*)(g1 + (size_t)b * ldm + col0 + bj * HALF + 4 * n); mv[bj][n] = *(const f32x4*)(gm + (size_t)b * 1024 + col0 + bj * HALF + 4 * n); }
#pragma unroll
        for (int ai = 0; ai < 2; ++ai)
#pragma unroll
            for (int m = 0; m < 4; ++m) { const size_t row = (size_t)(row0 + ai * HALF + m * 16); float ss = 0.f;
#pragma unroll
                for (int bj = 0; bj < 2; ++bj) { const size_t off = row * 1024 + col0 + bj * HALF;
                    const f32x4 xa = *(const f32x4*)(x + off), xb = *(const f32x4*)(x + off + 4);
                    const f32x4 d0 = gv[bj][0] * acc[ai][bj][m][0], d1 = gv[bj][1] * acc[ai][bj][m][1]; const f32x4 r0 = xa + d0, r1 = xb + d1;
                    { u32x4 wd; PG8_PACK8(wd, d0, d1); *(u32x4*)(MIX + off) = wd; }
                    ss += (r0[0] * r0[0] + r0[1] * r0[1]) + (r0[2] * r0[2] + r0[3] * r0[3]) + (r1[0] * r1[0] + r1[1] * r1[1]) + (r1[2] * r1[2] + r1[3] * r1[3]);
                    const f32x4 h0 = r0 * mv[bj][0], h1 = r1 * mv[bj][1]; u32x4 w; PG8_PACK8(w, h0, h1); *(u32x4*)(XG + off) = w; }
                ss += __shfl_xor(ss, 16); ss += __shfl_xor(ss, 32);
                if (fq == 0) atomicAdd(rowss + row, ss); }
    }
};
struct EpiMlp1 {
    static constexpr bool PERM = true, AFTER_DRAIN = false;
    bf16_t* O; const float* rowss; const float* shb;
    __device__ __forceinline__ void operator()(const f32x4 (&acc)[2][2][4][2], const Unit& u, int wr, int wc, int fr, int fq) const {
        const int row0 = u.pm * BM + wr * 64 + fr; const int col0 = u.pn * BM + wc * 32 + 8 * fq; const int b = u.pm >> 3;
        f32x4 bv[2][2];
#pragma unroll
        for (int bj = 0; bj < 2; ++bj)
#pragma unroll
            for (int n = 0; n < 2; ++n) bv[bj][n] = *(const f32x4*)(shb + (size_t)b * 4096 + col0 + bj * HALF + 4 * n);
#pragma unroll
        for (int ai = 0; ai < 2; ++ai)
#pragma unroll
            for (int m = 0; m < 4; ++m) { const size_t row = (size_t)(row0 + ai * HALF + m * 16);
                const float rstd = 1.0f / sqrtf(rowss[row] * (1.0f / 1024.0f) + 1e-6f);
#pragma unroll
                for (int bj = 0; bj < 2; ++bj) { f32x4 v0 = acc[ai][bj][m][0] * rstd + bv[bj][0], v1 = acc[ai][bj][m][1] * rstd + bv[bj][1];
#pragma unroll
                    for (int e = 0; e < 4; ++e) { const float a = fmaxf(v0[e], 0.f), c = fmaxf(v1[e], 0.f); v0[e] = a * a; v1[e] = c * c; }
                    u32x4 w; PG8_PACK8(w, v0, v1); *(u32x4*)(O + row * 4096 + col0 + bj * HALF) = w; } }
    }
};
struct EpiOut {
    static constexpr bool PERM = true, AFTER_DRAIN = false;
    const float* x; const bf16_t* MIX; float* out; const float* g2; const float* b2; int ldm;
    __device__ __forceinline__ void operator()(const f32x4 (&acc)[2][2][4][2], const Unit& u, int wr, int wc, int fr, int fq) const {
        const int row0 = u.pm * BM + wr * 64 + fr; const int col0 = u.pn * BM + wc * 32 + 8 * fq; const int b = u.pm >> 3;
        f32x4 gv[2][2], bv[2][2];
#pragma unroll
        for (int bj = 0; bj < 2; ++bj)
#pragma unroll
            for (int n = 0; n < 2; ++n) { gv[bj][n] = *(const f32x4*)(g2 + (size_t)b * ldm + col0 + bj * HALF + 4 * n); bv[bj][n] = *(const f32x4*)(b2 + col0 + bj * HALF + 4 * n); }
#pragma unroll
        for (int ai = 0; ai < 2; ++ai)
#pragma unroll
            for (int m = 0; m < 4; ++m) { const size_t row = (size_t)(row0 + ai * HALF + m * 16);
#pragma unroll
                for (int bj = 0; bj < 2; ++bj) { const size_t off = row * 1024 + col0 + bj * HALF; float* p = out + off;
                    const u32x4 mw = *(const u32x4*)(MIX + off); f32x4 m0, m1; PG8_UNPACK8(m0, m1, mw);
                    const f32x4 xa = *(const f32x4*)(x + off) + m0, xb = *(const f32x4*)(x + off + 4) + m1;
                    *(f32x4*)p = xa + gv[bj][0] * (acc[ai][bj][m][0] + bv[bj][0]); *(f32x4*)(p + 4) = xb + gv[bj][1] * (acc[ai][bj][m][1] + bv[bj][1]); }
                asm volatile("" ::: "memory"); }
    }
};

template <size_t OQ, size_t OKC, size_t OVC, size_t OUH, size_t OSGA, size_t OSGS, size_t ORC, size_t ORS> struct EpiIn {
    static constexpr bool PERM = true, AFTER_DRAIN = false;
    unsigned char* wsb; const float *gq, *gk;
    __device__ __forceinline__ void operator()(const f32x4 (&acc)[2][2][4][2], const Unit& u, int wr, int wc, int fr, int fq) const {
        bf16_t* const Q = (bf16_t*)(wsb + OQ); bf16_t* const KC = (bf16_t*)(wsb + OKC); bf16_t* const VC = (bf16_t*)(wsb + OVC); bf16_t* const UH = (bf16_t*)(wsb + OUH); bf16_t* const SGA = (bf16_t*)(wsb + OSGA); bf16_t* const SGS = (bf16_t*)(wsb + OSGS);
        const float* const RC = (const float*)(wsb + ORC); const float* const RS = (const float*)(wsb + ORS);
        const int pn = u.pn; const bool lat = u.pm < 128;
        const int rowt = u.pm * BM + wr * 64 + fr;
        if (pn < 5) {
            const bool isq = pn < 4; const float* gn = isq ? gq : gk;
            f32x4 gg[2][2];
#pragma unroll
            for (int bj = 0; bj < 2; ++bj)
#pragma unroll
                for (int n = 0; n < 2; ++n) gg[bj][n] = *(const f32x4*)(gn + 32 * bj + 16 * n + 4 * fq);
#pragma unroll
            for (int ai = 0; ai < 2; ++ai)
#pragma unroll
                for (int m = 0; m < 4; ++m) { const int row = rowt + ai * HALF + m * 16;
                    float ss = 0.f;
#pragma unroll
                    for (int bj = 0; bj < 2; ++bj)
#pragma unroll
                        for (int n = 0; n < 2; ++n) { const f32x4 v = acc[ai][bj][m][n]; ss += (v[0] * v[0] + v[1] * v[1]) + (v[2] * v[2] + v[3] * v[3]); }
                    ss += __shfl_xor(ss, 16); ss += __shfl_xor(ss, 32);
                    const float r = (isq ? 0.18033688011112042f : 1.0f) / sqrtf(ss * (1.0f / 64.0f) + 1e-6f);
                    const int t = row & 2047;
                    bf16_t* dst;
                    if (isq) dst = Q + (size_t)row * 1024 + pn * 256 + wc * 64 + 8 * fq;
                    else { const int rc = row - 32768; const size_t krow = lat ? (size_t)(row >> 11) * 2304 + t : (size_t)(rc >> 8) * 2304 + 2048 + (rc & 255); dst = KC + krow * 256 + wc * 64 + 8 * fq; }
#pragma unroll
                    for (int bj = 0; bj < 2; ++bj) { f32x4 x1 = acc[ai][bj][m][0] * r * gg[bj][0], x2 = acc[ai][bj][m][1] * r * gg[bj][1];
                        if (lat) { const int pos = bj == 0 ? (t >> 6) : (t & 63); const f32x4 c4 = *(const f32x4*)(RC + pos * 16 + 4 * fq), s4 = *(const f32x4*)(RS + pos * 16 + 4 * fq);
                            const f32x4 o1 = x1 * c4 - x2 * s4, o2 = x2 * c4 + x1 * s4; x1 = o1; x2 = o2; }
                        u32x4 w; PG8_PACK8(w, x1, x2); *(u32x4*)(dst + 32 * bj) = w; }
                    asm volatile("" ::: "memory"); }
        } else if (pn == 5) {
#pragma unroll
            for (int ai = 0; ai < 2; ++ai)
#pragma unroll
                for (int m = 0; m < 4; ++m) { const int row = rowt + ai * HALF + m * 16; const int rc = row - 32768;
                    const size_t krow = lat ? (size_t)(row >> 11) * 2304 + (row & 2047) : (size_t)(rc >> 8) * 2304 + 2048 + (rc & 255);
#pragma unroll
                    for (int bj = 0; bj < 2; ++bj) { u32x4 w; PG8_PACK8(w, acc[ai][bj][m][0], acc[ai][bj][m][1]); *(u32x4*)(VC + krow * 256 + bj * HALF + wc * 32 + 8 * fq) = w; } }
        } else if (pn < 8) {
#pragma unroll
            for (int ai = 0; ai < 2; ++ai)
#pragma unroll
                for (int m = 0; m < 4; ++m) { const int row = rowt + ai * HALF + m * 16; const int mc = lat ? row : row - 32768; const int nidx = (lat ? 0 : 1024) + (mc >> 5), sidx = mc & 31;
#pragma unroll
                    for (int bj = 0; bj < 2; ++bj) { const int ch0 = 256 * (pn - 6) + bj * HALF + wc * 32 + 8 * fq;
                        u32x4 w; PG8_PACK8(w, acc[ai][bj][m][0], acc[ai][bj][m][1]); *(u32x4*)(UH + ((size_t)((ch0 >> 4) * 1280 + nidx)) * 768 + sidx * 16 + (ch0 & 15)) = w; } }
        } else {
            bf16_t* G_ = (pn < 12) ? SGA : SGS;
#pragma unroll
            for (int ai = 0; ai < 2; ++ai)
#pragma unroll
                for (int m = 0; m < 4; ++m) { const int row = rowt + ai * HALF + m * 16;
#pragma unroll
                    for (int bj = 0; bj < 2; ++bj) { f32x4 v0 = acc[ai][bj][m][0], v1 = acc[ai][bj][m][1];
#pragma unroll
                        for (int e = 0; e < 4; ++e) { v0[e] = sigm_(v0[e]); v1[e] = sigm_(v1[e]); }
                        u32x4 w; PG8_PACK8(w, v0, v1); *(u32x4*)(G_ + (size_t)row * 1024 + (pn & 3) * 256 + bj * HALF + wc * 32 + 8 * fq) = w; } }
        }
    }
};

struct EpiMerge {
    static constexpr bool PERM = true, AFTER_DRAIN = false;
    bf16_t* O; const bf16_t* SGA; const bf16_t* SGS;
    __device__ __forceinline__ void mid(f32x4 (&acc)[2][2][4][2], const Unit& u, int wr, int wc, int fr, int fq) const {
        int row0 = u.pm * BM + wr * 64 + fr; int col0 = u.pn * BM + wc * 32 + 8 * fq;
        asm volatile("" : "+v"(row0), "+v"(col0));
#pragma unroll
        for (int ai = 0; ai < 2; ++ai)
#pragma unroll
            for (int m = 0; m < 4; ++m) { const size_t row = (size_t)(row0 + ai * HALF + m * 16);
#pragma unroll
                for (int bj = 0; bj < 2; ++bj) { const size_t off = row * 1024 + col0 + bj * HALF;
                    const u32x4 aw = *(const u32x4*)(SGA + off), sw = *(const u32x4*)(SGS + off); f32x4 a0, a1, s0, s1; PG8_UNPACK8(a0, a1, aw); PG8_UNPACK8(s0, s1, sw);
#pragma unroll
                    for (int e = 0; e < 4; ++e) { acc[ai][bj][m][0][e] *= s0[e] * __builtin_amdgcn_rcpf(fmaxf(a0[e], 1e-30f)); acc[ai][bj][m][1][e] *= s1[e] * __builtin_amdgcn_rcpf(fmaxf(a1[e], 1e-30f)); } }
                asm volatile("" : "+v"(acc[ai][0][m][0]), "+v"(acc[ai][0][m][1]), "+v"(acc[ai][1][m][0]), "+v"(acc[ai][1][m][1]) :: "memory"); }
    }
    __device__ __forceinline__ void operator()(const f32x4 (&acc)[2][2][4][2], const Unit& u, int wr, int wc, int fr, int fq) const {
        const int row0 = u.pm * BM + wr * 64 + fr; const int col0 = u.pn * BM + wc * 32 + 8 * fq;
#pragma unroll
        for (int ai = 0; ai < 2; ++ai)
#pragma unroll
            for (int m = 0; m < 4; ++m) { const size_t row = (size_t)(row0 + ai * HALF + m * 16);
#pragma unroll
                for (int bj = 0; bj < 2; ++bj) { const size_t off = row * 1024 + col0 + bj * HALF;
                    const u32x4 aw = *(const u32x4*)(SGA + off); f32x4 a0, a1; PG8_UNPACK8(a0, a1, aw);
                    const f32x4 v0 = acc[ai][bj][m][0] * a0, v1 = acc[ai][bj][m][1] * a1;
                    u32x4 w; PG8_PACK8(w, v0, v1); *(u32x4*)(O + off) = w; } }
    }
};
}

constexpr int NB = 16, SEQ = 2048, DM = 1024, NCTX = 256;
constexpr int MLAT = NB * SEQ, MCTX = NB * NCTX, MALL = MLAT + MCTX;
constexpr int WIN = 4096, NH = 16, NKV = 4, HD = 64, DSSM = 512, NG = 32, SGRP = 16, PST = 64, DFF = 4096;
constexpr int OFF_Q = 0, OFF_K = 1024, OFF_V = 1280, OFF_U = 1536, OFF_GA = 2048, OFF_GS = 3072;
constexpr int LTOT = NCTX + SEQ;
constexpr float NORM_EPS = 1e-6f;

constexpr size_t MiB = 1u << 20;
constexpr size_t WS_CTL = 0, CTL_ZERO_BYTES = 64 * 1024;
constexpr size_t WS_MV = 128 * 1024;
constexpr size_t WS_ROPEC = 1 * MiB + 432 * 1024, WS_ROPES = 1 * MiB + 436 * 1024;
constexpr size_t WS_KCG = 2 * MiB;
constexpr size_t WS_WIN = 4 * MiB, WS_W1 = 12 * MiB, WS_W2 = 20 * MiB, WS_BCAT = 28 * MiB  , WS_WOUT = 32 * MiB, WS_WGLU = 34 * MiB;
constexpr size_t WS_H = 36 * MiB;
constexpr size_t WS_P = 108 * MiB;
constexpr size_t WS_Q = 108 * MiB;
constexpr size_t WS_KC = 172 * MiB, WS_VC = 190 * MiB;
constexpr size_t WS_SGA = 208 * MiB, WS_SGS = 272 * MiB;
constexpr size_t WS_UH = 336 * MiB;
constexpr size_t WS_YG = 396 * MiB;
constexpr size_t WS_X1 = 364 * MiB;
constexpr size_t WS_BTC = 460 * MiB;
constexpr size_t WS_BTA = 484 * MiB;
constexpr size_t WS_END = 492 * MiB;
constexpr size_t WS_S = 36 * MiB;
constexpr size_t WS_MG = 36 * MiB;
constexpr int ACAT_LD = 1536;
constexpr int TC = 32, NROW_G = 1280;
constexpr int CW_BAR = 4096;
constexpr int CW_CNT = 8192;
constexpr size_t WS_ROWSS = 640 * 1024;
constexpr size_t WS_SHB = 768 * 1024;
constexpr size_t WS_GM = 1 * MiB;

#define GAS __attribute__((address_space(1)))
#define LAS __attribute__((address_space(3)))
typedef unsigned short bf16;
typedef unsigned v4u __attribute__((ext_vector_type(4)));
typedef unsigned v2u __attribute__((ext_vector_type(2)));
typedef float f32x4 __attribute__((ext_vector_type(4)));
typedef float f32x2 __attribute__((ext_vector_type(2)));
#define DEV __device__ __forceinline__
#define LDS_WAIT() asm volatile("s_waitcnt lgkmcnt(0)" ::: "memory")
DEV unsigned f2bf(float f) { unsigned u = __builtin_bit_cast(unsigned, f); return (u + 0x7fffu + ((u >> 16) & 1u)) >> 16; }
DEV unsigned pk2(float lo, float hi) { return f2bf(lo) | (f2bf(hi) << 16); }
DEV float bf2f(unsigned b) { return __builtin_bit_cast(float, b << 16); }
DEV float bflo(unsigned w) { return __builtin_bit_cast(float, w << 16); }
DEV float bfhi(unsigned w) { return __builtin_bit_cast(float, w & 0xffff0000u); }
DEV float wave_sum(float v) {
#pragma unroll
    for (int o = 1; o < 64; o <<= 1) v += __shfl_xor(v, o);
    return v;
}
DEV float sigmoidf_(float x) { return 1.0f / (1.0f + expf(-x)); }
DEV float gelu_tanh(float x) { const float u = 0.7978845608028654f * (x + 0.044715f * x * x * x); return 0.5f * x * (1.0f + tanhf(u)); }


DEV void cnt_arrive(unsigned* cnt) {
    asm volatile("s_waitcnt vmcnt(0)" ::: "memory");
    __syncthreads();
    if (threadIdx.x == 0) { __builtin_amdgcn_fence(__ATOMIC_RELEASE, "agent"); asm volatile("s_waitcnt vmcnt(0)" ::: "memory"); __hip_atomic_fetch_add(cnt, 1u, __ATOMIC_RELAXED, __HIP_MEMORY_SCOPE_AGENT); }
}
DEV void cnt_wait(unsigned* cnt, unsigned target, unsigned* tmo) {
    if (threadIdx.x == 0) {
        unsigned sp = 0;
        while (__hip_atomic_load(cnt, __ATOMIC_RELAXED, __HIP_MEMORY_SCOPE_AGENT) < target) { __builtin_amdgcn_s_sleep(2); if (++sp > (1u << 22)) { atomicAdd(tmo, 1u); break; } }
        __builtin_amdgcn_fence(__ATOMIC_ACQUIRE, "agent"); asm volatile("s_waitcnt vmcnt(0)" ::: "memory");
    }
    __syncthreads();
}

struct Args { const float* in[28]; float* out; unsigned char* ws; int ph_lo, ph_hi, li, pad; };

template <bool QKPERM> DEV void transpose_item(const float* W, int K, int N, bf16* WT, LAS float* scr, int item, int lane, int ldt = 0) {
    if (ldt == 0) ldt = K;
    const int nblk = N / 32, kb = item / nblk, nb = item % nblk, k0 = 64 * kb, n0 = 32 * nb;
    float wv[32];
#pragma unroll
    for (int i = 0; i < 32; ++i) { const int kk = 2 * i + (lane >> 5); wv[i] = W[(size_t)(k0 + kk) * N + n0 + (lane & 31)]; }
#pragma unroll
    for (int i = 0; i < 32; ++i) { const int kk = 2 * i + (lane >> 5); scr[kk * 33 + (lane & 31)] = wv[i]; }
    LDS_WAIT(); asm volatile("" ::: "memory");
    const int c = lane & 7;
#pragma unroll
    for (int j = 0; j < 4; ++j) { const int n = (lane >> 3) + 8 * j; const LAS float* s = scr + (8 * c) * 33 + n;
        v4u o; o.x = pk2(s[0 * 33], s[1 * 33]); o.y = pk2(s[2 * 33], s[3 * 33]); o.z = pk2(s[4 * 33], s[5 * 33]); o.w = pk2(s[6 * 33], s[7 * 33]);
        int nr = n0 + n; if (QKPERM && nr < 1280) { const int cl = nr & 255; nr = (nr & ~255) + 128 * ((cl >> 5) & 1) + 32 * (cl >> 6) + 8 * ((cl >> 2) & 3) + 4 * ((cl >> 4) & 1) + (cl & 3); }
        *(v4u*)(WT + (size_t)nr * ldt + k0 + 8 * c) = o; }
    LDS_WAIT(); asm volatile("" ::: "memory");
}

typedef float f32x16m __attribute__((ext_vector_type(16)));
DEV void ph_modvec(const Args& a, LAS unsigned char* lds, int tid, int lane, int wave, int bid, int G) {
    const float* c = a.in[1]; const float* cc = a.in[3]; const float* wm = a.in[4]; const float* bm = a.in[5];
    float* MV = (float*)(a.ws + WS_MV);
    LAS float* SC = (LAS float*)lds;
    LAS float* PR = (LAS float*)(lds + 71680);
    const int li = lane & 31, lk = lane >> 5;
    for (int slab = bid; slab < 256; slab += G) {
        float bv[64];
        { const float* wp = wm + (size_t)(128 * wave + lk) * 6144 + slab * 24 + (li < 24 ? li : 0);
#pragma unroll
          for (int t = 0; t < 64; ++t) bv[t] = wp[(size_t)(2 * t) * 6144]; }
        if (slab == bid) { for (int e = tid; e < 17 * 1024; e += 512) { const float cv = (e < 16 * 1024) ? c[e] : cc[e - 16 * 1024]; SC[(e >> 10) * 1025 + (e & 1023)] = cv / (1.0f + expf(-cv)); } }
        __syncthreads();
        f32x16m acc = {0.f, 0.f, 0.f, 0.f, 0.f, 0.f, 0.f, 0.f, 0.f, 0.f, 0.f, 0.f, 0.f, 0.f, 0.f, 0.f};
        const LAS float* sp = SC + (li < 17 ? li : 0) * 1025 + 128 * wave + lk;
#pragma unroll
        for (int t = 0; t < 64; ++t) { const float av = (li < 17) ? sp[2 * t] : 0.f; const float bw = (li < 24) ? bv[t] : 0.f; acc = __builtin_amdgcn_mfma_f32_32x32x2f32(av, bw, acc, 0, 0, 0); }
#pragma unroll
        for (int r = 0; r < 16; ++r) { const int row = (r & 3) + 8 * (r >> 2) + 4 * lk; if (row < 17 && li < 24) PR[(wave * 17 + row) * 24 + li] = acc[r]; }
        __syncthreads();
        if (tid < 408) { float sum = bm[slab * 24 + (tid % 24)];
#pragma unroll
            for (int w = 0; w < 8; ++w) sum += PR[w * 408 + tid];
            MV[(tid / 24) * 6144 + slab * 24 + (tid % 24)] = sum; }
        __syncthreads();
    }
}

DEV void ph_prologue(const Args& a, LAS unsigned char* lds, int tid, int lane, int wave, int bid, int G) {
    unsigned char* ws = a.ws;
    LAS float* scr = (LAS float*)(lds + wave * 16384);
    const int gw = bid * 8 + wave, NGW = G * 8;
    for (int it = gw; it < 16 * 128; it += NGW) transpose_item<true>(a.in[8], 1024, 4096, (bf16*)(ws + WS_WIN), scr, it, lane);
    {
        const int gt = bid * 512 + tid;
        for (int e = gt; e < (128 + 256) * 1024 / 16; e += G * 512) ((f32x4*)(ws + WS_ROWSS))[e] = (f32x4){0.f, 0.f, 0.f, 0.f};
        if (gt < 1024) {
            const int pos = gt >> 4, j = gt & 15;
            const float invf = powf(10000.0f, -(float)j / 16.0f);
            const float ang = (float)pos * invf;
            ((float*)(ws + WS_ROPEC))[gt] = cosf(ang); ((float*)(ws + WS_ROPES))[gt] = sinf(ang);
        }
    }
}

DEV void ph_transposes_rest(const Args& a, LAS unsigned char* lds, int lane, int wave, int gw, int NGW) {
    unsigned char* ws = a.ws; LAS float* scr = (LAS float*)(lds + wave * 16384);
    constexpr int I_1 = 16 * 128, I_2 = 64 * 32, I_A = 16 * 32, I_O = 16 * 32, I_S = 8 * 32, I_G = 8 * 16;
    constexpr int NITEMS = I_1 + I_2 + I_A + I_O + I_S + I_G;
    for (int it = gw; it < NITEMS; it += NGW) {
        int r = it;
        if (r < I_1) { transpose_item<false>(a.in[24], 1024, 4096, (bf16*)(ws + WS_W1), scr, r, lane); continue; } r -= I_1;
        if (r < I_2) { transpose_item<false>(a.in[26], 4096, 1024, (bf16*)(ws + WS_W2), scr, r, lane); continue; } r -= I_2;
        if (r < I_A) { transpose_item<false>(a.in[21], 1024, 1024, (bf16*)(ws + WS_BCAT) + 512, scr, r, lane, 1536); continue; } r -= I_A;
        if (r < I_O) { transpose_item<false>(a.in[23], 1024, 1024, (bf16*)(ws + WS_WOUT), scr, r, lane); continue; } r -= I_O;
        if (r < I_S) { transpose_item<false>(a.in[22], 512, 1024, (bf16*)(ws + WS_BCAT), scr, r, lane, 1536); continue; } r -= I_S;
        transpose_item<false>(a.in[19], 512, 512, (bf16*)(ws + WS_WGLU), scr, r, lane);
    }
}

DEV void ph_normmod(const Args& a, int lane, int wave, int bid, int G) {
    const int gw = bid * 8 + wave, NGW = G * 8;
    const float* MV = (const float*)(a.ws + WS_MV); const float* gn = a.in[6]; bf16* H = (bf16*)(a.ws + WS_H);
    const int rpw = (MALL + NGW - 1) / NGW;
    const int m0 = gw * rpw, m1 = (m0 + rpw < MALL) ? m0 + rpw : MALL;
    f32x4 nx[3][4];
#define NM_LOAD(slot, m_) do { const int mm_ = (m_); if (mm_ < m1) { const float* xr_ = (mm_ < MLAT) ? a.in[0] + (size_t)mm_ * DM : a.in[2] + (size_t)(mm_ - MLAT) * DM; \
        _Pragma("unroll") for (int j = 0; j < 4; ++j) nx[slot][j] = ((const f32x4*)xr_)[lane + 64 * j]; } } while (0)
#define NM_ROW(slot, m_) do { const int mr_ = (m_); if (mr_ < m1) { const float* mv = MV + ((mr_ < MLAT) ? (mr_ / SEQ) : 16) * 6144; \
        f32x4 v[4]; float ss = 0.f; \
        _Pragma("unroll") for (int j = 0; j < 4; ++j) { v[j] = nx[slot][j]; ss += (v[j].x * v[j].x + v[j].y * v[j].y) + (v[j].z * v[j].z + v[j].w * v[j].w); } \
        NM_LOAD(slot, mr_ + 3); \
        const float rstd = 1.0f / sqrtf(wave_sum(ss) * (1.0f / DM) + NORM_EPS); \
        _Pragma("unroll") for (int j = 0; j < 4; ++j) { const int k4 = lane + 64 * j; \
            const f32x4 g4 = ((const f32x4*)gn)[k4], sh = ((const f32x4*)mv)[k4], sc = ((const f32x4*)(mv + 1024))[k4]; \
            const f32x4 h = v[j] * rstd * g4 * (sc + 1.0f) + sh; \
            v2u o; o.x = pk2(h.x, h.y); o.y = pk2(h.z, h.w); ((v2u*)(H + (size_t)mr_ * DM))[k4] = o; } } } while (0)
    NM_LOAD(0, m0); NM_LOAD(1, m0 + 1); NM_LOAD(2, m0 + 2);
    for (int m = m0; m < m1; m += 3) { NM_ROW(0, m); NM_ROW(1, m + 1); NM_ROW(2, m + 2); }
#undef NM_LOAD
#undef NM_ROW
}

DEV void ph_mlp_consts(const Args& a, LAS unsigned char* lds, int tid, int lane, int wave, int bid, int G) {
    const float* MV = (const float*)(a.ws + WS_MV); float* GM = (float*)(a.ws + WS_GM); float* SHB = (float*)(a.ws + WS_SHB);
    for (int e = bid * 512 + tid; e < 16 * 1024; e += G * 512) { const int b = e >> 10, k = e & 1023; GM[e] = a.in[7][k] * (1.0f + MV[b * 6144 + 4096 + k]); }
    LAS float* scr = (LAS float*)(lds + wave * 16384);
    const int gw = bid * 8 + wave, NGW = G * 8; const float* w1 = a.in[24]; const float* b1 = a.in[25];
    for (int it = NGW - 1 - gw; it < 64 * 32; it += NGW) {
        const int cb = it & 63, ks = it >> 6, col = cb * 64 + lane, k0 = ks * 32;
        float w[32];
#pragma unroll
        for (int j = 0; j < 32; ++j) w[j] = w1[(size_t)(k0 + j) * 4096 + col];
        for (int i = lane; i < 16 * 32; i += 64) { const int b = i >> 5, kk = i & 31; scr[i] = MV[b * 6144 + 3072 + k0 + kk]; }
        LDS_WAIT(); asm volatile("" ::: "memory");
        const float bb = (ks == 0) ? b1[col] : 0.f;
#pragma unroll
        for (int b = 0; b < 16; ++b) { float acc = bb;
#pragma unroll
            for (int j4 = 0; j4 < 8; ++j4) { const f32x4 s4 = *(const LAS f32x4*)(scr + b * 32 + 4 * j4); acc += (s4.x * w[4 * j4] + s4.y * w[4 * j4 + 1]) + (s4.z * w[4 * j4 + 2] + s4.w * w[4 * j4 + 3]); }
            atomicAdd(SHB + b * 4096 + col, acc); }
        LDS_WAIT(); asm volatile("" ::: "memory");
    }
}

DEV void ph_attn(const Args& a, char* lds_generic, int bid, int G, int r0, int r1) {
    const attn_body::bf16* Q = (const attn_body::bf16*)(a.ws + WS_Q); const attn_body::bf16* KC = (const attn_body::bf16*)(a.ws + WS_KC); const attn_body::bf16* VC = (const attn_body::bf16*)(a.ws + WS_VC);
    attn_body::bf16* AO = (attn_body::bf16*)a.out + 512;
    const int vcu = (G % 8 == 0) ? (bid % 8) * (G / 8) + bid / 8 : bid;
#pragma nounroll
    for (int r = r0; r < r1; ++r) { const int L = vcu + r * G; if (L >= NB * NH * (SEQ / 256)) break;
        const int grp = L >> 5, j = L & 31; const int b = grp >> 2, kvh = grp & 3; const int h = kvh * 4 + (j >> 3), qb = j & 7;
        const attn_body::bf16* kb = KC + (size_t)b * LTOT * 256; const attn_body::bf16* vb = VC + (size_t)b * LTOT * 256;
        attn_body::attn_unit<8, DM, 256, ACAT_LD>(h, qb, Q + (size_t)b * SEQ * DM, kb, vb, kb + (size_t)SEQ * 256, vb + (size_t)SEQ * 256, AO + (size_t)b * SEQ * ACAT_LD, lds_generic);
    }
}

DEV void ssm_disc(const Args& a, int idx, f32x2& av, f32x2& coef) {
    const int dg = idx >> 6;
    const float dt = expf(a.in[13][dg]);
    const float lre = a.in[11][idx], lim = a.in[12][idx];
    const float zr = lre * dt, zi = lim * dt;
    const float ex = expf(zr), sn = sinf(zi), cs = cosf(zi);
    const float sh = sinf(0.5f * zi), em1 = expm1f(zr);
    const float nre = em1 * cs - 2.0f * sh * sh, nim = ex * sn;
    const float den = lre * lre + lim * lim;
    av = (f32x2){ex * cs, ex * sn}; coef = (f32x2){(nre * lre + nim * lim) / den, (nim * lre - nre * lim) / den};
}
DEV f32x2 cmul(f32x2 x, f32x2 y) { return (f32x2){x.x * y.x - x.y * y.y, x.x * y.y + x.y * y.x}; }

DEV void ssm_kc_item(const Args& a, LAS float* scr, int item, int lane) {
    const int g = item / 63, di = item % 63, dl = di - 31;
    LAS f32x2* X = (LAS f32x2*)scr;
    LAS f32x2* Cw = X + 1024;
    const int h = lane >> 2, hq = lane & 3;
    float acc0 = 0.f, acc1 = 0.f, acc2 = 0.f, acc3 = 0.f;
    for (int dir = 0; dir < 2; ++dir) {
        if ((dir == 0 && dl < 0) || (dir == 1 && dl > 0)) continue;
        const int idx = (dir * 32 + g) * 64 + lane; f32x2 av, coef; ssm_disc(a, idx, av, coef);
        int e = dl < 0 ? -dl : dl; f32x2 pw = (f32x2){1.f, 0.f}, bs = av;
        while (e) { if (e & 1) pw = cmul(pw, bs); bs = cmul(bs, bs); e >>= 1; }
        const f32x2 pc = cmul(pw, coef);
#pragma unroll
        for (int hp = 0; hp < 16; ++hp) X[lane * 16 + hp] = cmul(pc, (f32x2){a.in[14][(size_t)idx * 16 + hp], a.in[15][(size_t)idx * 16 + hp]});
#pragma unroll
        for (int hh = 0; hh < 16; ++hh) Cw[hh * 64 + lane] = (f32x2){a.in[16][(size_t)((dir * 32 + g) * 16 + hh) * 64 + lane], a.in[17][(size_t)((dir * 32 + g) * 16 + hh) * 64 + lane]};
        LDS_WAIT(); asm volatile("" ::: "memory");
        for (int p = 0; p < 64; ++p) { const f32x2 c = Cw[h * 64 + p]; const LAS f32x4* xp = (const LAS f32x4*)(X + p * 16 + 4 * hq); const f32x4 xa = xp[0], xb = xp[1];
            acc0 += c.x * xa.x - c.y * xa.y; acc1 += c.x * xa.z - c.y * xa.w; acc2 += c.x * xb.x - c.y * xb.y; acc3 += c.x * xb.z - c.y * xb.w; }
        LDS_WAIT(); asm volatile("" ::: "memory");
    }
    v2u o; o.x = pk2(acc0, acc1); o.y = pk2(acc2, acc3);
    *(v2u*)((bf16*)(a.ws + WS_KCG) + (size_t)item * 256 + h * 16 + 4 * hq) = o;
}

DEV void ssm_expand(const Args& a, LAS unsigned char* lds, int tid, int item) {
    const int g = item >> 3, q = item & 7;
    LAS f32x2* PW = (LAS f32x2*)lds;
    LAS f32x2* BBl = (LAS f32x2*)(lds + 33792);
    LAS f32x2* Cl = (LAS f32x2*)(lds + 33792 + 16384);
    __syncthreads();
    if (tid < 128) {
        const int dir = tid >> 6, p = tid & 63, idx = (dir * 32 + g) * 64 + p;
        f32x2 av, coef; ssm_disc(a, idx, av, coef);
        f32x2 w = (f32x2){1.f, 0.f};
        for (int k = 0; k <= 32; ++k) { PW[tid * 33 + k] = w; w = cmul(w, av); }
#pragma unroll
        for (int h = 0; h < 16; ++h) BBl[tid * 16 + h] = cmul(coef, (f32x2){a.in[14][(size_t)idx * 16 + h], a.in[15][(size_t)idx * 16 + h]});
    }
    for (int e = tid; e < 2048; e += 512) { const int dir = e >> 10, hp = e & 1023; Cl[e] = (f32x2){a.in[16][(size_t)(dir * 32 + g) * 1024 + hp], a.in[17][(size_t)(dir * 32 + g) * 1024 + hp]}; }
    __syncthreads();
    bf16* BtC = (bf16*)(a.ws + WS_BTC) + (size_t)g * 512 * 768; bf16* BtA = (bf16*)(a.ws + WS_BTA) + (size_t)g * 256 * 512; const bf16* KCG = (const bf16*)(a.ws + WS_KCG) + (size_t)g * 63 * 256;
#pragma unroll
    for (int i = 0; i < 8; ++i) { const int cid = tid + 512 * i, row = cid >> 6, tl = row >> 4, h = row & 15, ch = cid & 63, sidx = ch >> 1, half = ch & 1;
        const int di = 4 * q + tl - sidx + 31;
        const v4u val = *(const v4u*)(KCG + (size_t)di * 256 + h * 16 + half * 8);
        *(v4u*)(BtC + (size_t)((4 * q + tl) * 16 + h) * 768 + sidx * 16 + half * 8) = val; }
    for (int e = tid; e < 64 * 128; e += 512) { const int row = e >> 7, pc = e & 127, tl = row >> 4, h = row & 15, t = 4 * q + tl, dir = pc >> 6, p = pc & 63;
        const int pe = dir == 0 ? t + 1 : 32 - t;
        const f32x2 cw = cmul(Cl[(dir * 16 + h) * 64 + p], PW[(dir * 64 + p) * 33 + pe]);
        *(unsigned*)(BtC + (size_t)(t * 16 + h) * 768 + 512 + 2 * pc) = pk2(cw.x, -cw.y); }
    for (int e = tid; e < 32 * 512; e += 512) { const int rl = e >> 9, k = e & 511, r = 32 * q + rl, dir = r >> 7, p = (r >> 1) & 63, ri = r & 1, sidx = k >> 4, hp = k & 15;
        const int pe = dir == 0 ? 31 - sidx : sidx;
        const f32x2 v = cmul(PW[(dir * 64 + p) * 33 + pe], BBl[(dir * 64 + p) * 16 + hp]);
        BtA[(size_t)r * 512 + k] = (bf16)f2bf(ri == 0 ? v.x : v.y); }
    LDS_WAIT();
}

DEV void ph_scan(const Args& a, int lane, int wave, int bid, int G) {
    const float* S = (const float*)(a.ws + WS_S); bf16* UH = (bf16*)(a.ws + WS_UH);
    for (int w = wave * G + bid; w < 1024; w += 8 * G) {
        const int dir = w & 1, g = (w >> 1) & 31, b = w >> 6;
        f32x2 av, coef; ssm_disc(a, (dir * 32 + g) * 64 + lane, av, coef);
        f32x2 a32 = av;
#pragma unroll
        for (int i = 0; i < 5; ++i) a32 = cmul(a32, a32);
        const int col = dir * 128 + 2 * lane;
        const float* Sg = S + (size_t)g * NROW_G * 256 + col; bf16* Ug = UH + (size_t)g * NROW_G * 768 + 512 + col;
        f32x2 H = (f32x2){0.f, 0.f};
        { f32x2 sv[8];
#pragma unroll
          for (int c = 0; c < 8; ++c) { const int cc = dir == 0 ? c : 7 - c; sv[c] = *(const f32x2*)(Sg + (size_t)(1024 + b * 8 + cc) * 256); }
#pragma unroll
          for (int c = 0; c < 8; ++c) { H = cmul(a32, H); H.x += sv[c].x; H.y += sv[c].y; } }
        for (int j0 = 0; j0 < 64; j0 += 8) {
            f32x2 sv[8];
#pragma unroll
            for (int c = 0; c < 8; ++c) { const int j = dir == 0 ? j0 + c : 63 - (j0 + c); sv[c] = *(const f32x2*)(Sg + (size_t)(b * 64 + j) * 256); }
#pragma unroll
            for (int c = 0; c < 8; ++c) { const int j = dir == 0 ? j0 + c : 63 - (j0 + c);
                *(unsigned*)(Ug + (size_t)(b * 64 + j) * 768) = pk2(H.x, H.y);
                H = cmul(a32, H); H.x += sv[c].x; H.y += sv[c].y; }
        }
    }
}
#define XB_TMO      128
#define XB_XCNT(j)  (256  + 64 * (j))
#define XB_XSUB(j)  (1280 + 64 * (j))
#define XB_XGEN(j)  (2304 + 64 * (j))
#define XB_TOP      3328
#define XB_TOPGEN   3392
#define XCD_BAR_WORDS 3456
#define XB_SPIN_CAP (1u << 18)

__device__ __forceinline__ unsigned xb_ld(unsigned* p)              { return __hip_atomic_load(p, __ATOMIC_RELAXED, __HIP_MEMORY_SCOPE_AGENT); }
__device__ __forceinline__ unsigned xb_add(unsigned* p, unsigned v) { return __hip_atomic_fetch_add(p, v, __ATOMIC_RELAXED, __HIP_MEMORY_SCOPE_AGENT); }
__device__ __forceinline__ unsigned xb_xcc_id() { return (unsigned)__builtin_amdgcn_s_getreg((3 << 11) | 20) & 0xFu; }
#define XB_SPIN(cond, bar) do { unsigned _sp = 0; while (cond) { __builtin_amdgcn_s_sleep(1); \
    if ((++_sp & 255u) == 0u) { if (xb_ld(&(bar)[XB_TMO])) break; if (_sp > XB_SPIN_CAP) { atomicAdd(&(bar)[XB_TMO], 1u); break; } } } } while (0)

struct XcdBarrier {
    unsigned* bar; unsigned x;
    volatile LAS unsigned* st;
};

__device__ __forceinline__ XcdBarrier xcd_barrier_post(unsigned* bar, volatile LAS unsigned* st) {
    XcdBarrier b; b.bar = bar; b.x = xb_xcc_id(); b.st = st;
    if (threadIdx.x == 0) (void)xb_add(&bar[XB_XCNT(b.x)], 1u);
    return b;
}
__device__ __forceinline__ void xcd_barrier_complete(unsigned* bar, unsigned x, unsigned& nloc, unsigned& nx) {
    const unsigned G = gridDim.x * gridDim.y * gridDim.z;
    unsigned sum, cnt, mine, sp = 0u;
    for (;;) {
        sum = 0u; cnt = 0u; mine = 0u;
#pragma unroll
        for (unsigned j = 0; j < 16; ++j) { const unsigned c = xb_ld(&bar[XB_XCNT(j)]); sum += c; cnt += (c > 0u) ? 1u : 0u; mine = (j == x) ? c : mine; }
        if (sum == G) break;
        __builtin_amdgcn_s_sleep(1);
        if ((++sp & 255u) == 0u) { if (xb_ld(&bar[XB_TMO])) break; if (sp > XB_SPIN_CAP) { atomicAdd(&bar[XB_TMO], 1u); break; } }
    }
    nloc = mine > 0u ? mine : 1u; nx = cnt > 0u ? cnt : 1u;
}

__device__ __forceinline__ void xcd_barrier(const XcdBarrier& b) {
    asm volatile("s_waitcnt vmcnt(0)" ::: "memory");
    __syncthreads();
    if (threadIdx.x == 0) {
        unsigned* bar = b.bar;
        __builtin_amdgcn_s_waitcnt(0);
        unsigned nloc = b.st[0], nx = b.st[1];
        if (nloc == 0u) { xcd_barrier_complete(bar, b.x, nloc, nx); b.st[0] = nloc; b.st[1] = nx; }
        const unsigned old = xb_add(&bar[XB_XSUB(b.x)], 1u);
        const unsigned gen = old / nloc;
        if (old + 1u == (gen + 1u) * nloc) {
            __builtin_amdgcn_fence(__ATOMIC_RELEASE, "agent");
            asm volatile("s_waitcnt vmcnt(0)" ::: "memory");
            const unsigned og = xb_add(&bar[XB_TOP], 1u);
            const unsigned tg = og / nx;
            if (og + 1u == (tg + 1u) * nx) xb_add(&bar[XB_TOPGEN], 1u);
            else XB_SPIN(xb_ld(&bar[XB_TOPGEN]) == tg, bar);
            __builtin_amdgcn_fence(__ATOMIC_ACQUIRE, "agent");
            xb_add(&bar[XB_XGEN(b.x)], 1u);
            asm volatile("s_waitcnt vmcnt(0)" ::: "memory");
        } else {
            XB_SPIN(xb_ld(&bar[XB_XGEN(b.x)]) == gen, bar);
            __builtin_amdgcn_fence(__ATOMIC_ACQUIRE, "agent");
            asm volatile("s_waitcnt vmcnt(0)" ::: "memory");
        }
    }
    __syncthreads();
}

constexpr int NPHASE = 7;
constexpr int LDS_BYTES = 147456;
constexpr int RING_BYTES = 131072, MISC_OFF = RING_BYTES + 320;


__global__ void __launch_bounds__(512, 2) mega(Args args) {
    extern __shared__ __attribute__((aligned(16))) unsigned char lds_raw[];
    LAS unsigned char* lds = (LAS unsigned char*)lds_raw;
    const int tid = threadIdx.x, lane = tid & 63, wave = __builtin_amdgcn_readfirstlane(tid >> 6);
    const int G = gridDim.x, bid = blockIdx.x;
    unsigned char* ws = args.ws;
    for (int u = tid; u < (LDS_BYTES - RING_BYTES) / 4; u += 512) ((LAS unsigned*)(lds + RING_BYTES))[u] = 0u;
    __syncthreads();
    const bool multi = (args.ph_hi - args.ph_lo) > 1;
    XcdBarrier bar; bar.bar = (unsigned*)(ws + WS_CTL) + CW_BAR; bar.x = 0; bar.st = nullptr;
    if (multi) bar = xcd_barrier_post((unsigned*)(ws + WS_CTL) + CW_BAR, (volatile LAS unsigned*)(lds + MISC_OFF) + 8);


    const int lo = args.ph_lo, hi = args.ph_hi;
#define IN(k) (lo <= (k) && (k) < hi)
#define SEAM(k) do { if (IN(k) && IN((k) + 1)) xcd_barrier(bar); } while (0)
#ifndef PH_MASK
#define PH_MASK 0x7f
#endif
#define PH_EN(k) ((PH_MASK >> (k)) & 1)
#ifndef WGM_IN
#define WGM_IN 4
#endif
#ifndef WGM_M1
#define WGM_M1 4
#endif
#ifndef DUP_MASK
#define DUP_MASK 0
#endif
#define RUN(k, ...) do { if (PH_EN(k) && IN(k)) { __VA_ARGS__; if ((DUP_MASK >> (k)) & 1) { xcd_barrier(bar); __VA_ARGS__; } } SEAM(k); } while (0)
    RUN(0, { unsigned* const cnt0 = (unsigned*)(ws + WS_CTL) + CW_CNT + 192; unsigned* const tmo0 = (unsigned*)(ws + WS_CTL) + CW_BAR + XB_TMO;
        ph_modvec(args, lds, tid, lane, wave, bid, G); cnt_arrive(cnt0);
        ph_prologue(args, lds, tid, lane, wave, bid, G); for (int it = bid * 8 + wave; it < 32 * 63; it += G * 8) ssm_kc_item(args, (LAS float*)(lds + wave * 16384), it, lane);
        cnt_wait(cnt0, (unsigned)G, tmo0); ph_normmod(args, lane, wave, bid, G); });
    RUN(1, { pg8::Gemm g{(const bf16*)(ws + WS_H), (const bf16*)(ws + WS_WIN), MLAT, WIN, DM, DM, DM}; pg8::SchedX S; S.so.init(MLAT, WIN, G, bid, WGM_IN); S.extra = (MCTX / 256) * 4; S.xpm0 = MLAT / 256; S.xpn0 = 4; S.xnn = 4;
        typedef pg8::EpiIn<WS_Q, WS_KC, WS_VC, WS_UH, WS_SGA, WS_SGS, WS_ROPEC, WS_ROPES> EpiInT; EpiInT E{ws, args.in[9], args.in[10]};
        pg8::gemm_phase<EpiInT, pg8::SchedX, true, true>(lds, g, S, E);
        if (G > 64 && bid >= 64) {
            const int sb = bid - 64, SG = G - 64;
            for (int it = sb; it < 256; it += SG) ssm_expand(args, lds, tid, it);
            __syncthreads();
            ph_transposes_rest(args, lds, lane, wave, sb * 8 + wave, SG * 8);
            ph_mlp_consts(args, lds, tid, lane, wave, sb, SG); } });
    RUN(2, {
        unsigned* const cnt = (unsigned*)(ws + WS_CTL) + CW_CNT; unsigned* const tmo = (unsigned*)(ws + WS_CTL) + CW_BAR + XB_TMO;
        { pg8::Gemm g{(const bf16*)(ws + WS_UH), (const bf16*)(ws + WS_BTA), 32 * NROW_G, 32 * 256, 512, 768, 512};
          pg8::SchedSsm S{160, G, bid, 0}; pg8::EpiS E{(float*)(ws + WS_S)};
          pg8::gemm_phase<pg8::EpiS, pg8::SchedSsm, true, true>(lds, g, S, E); }
        cnt_arrive(cnt + 0);
        ph_attn(args, (char*)lds_raw, bid, G, 0, 2);
        cnt_wait(cnt + 0, (unsigned)G, tmo); ph_scan(args, lane, wave, bid, G); cnt_arrive(cnt + 64);
        ph_attn(args, (char*)lds_raw, bid, G, 2, 4);
        cnt_wait(cnt + 64, (unsigned)G, tmo);
        { pg8::Gemm g{(const bf16*)(ws + WS_UH), (const bf16*)(ws + WS_BTC), 32 * NROW_G, 32 * 512, 768, 768, 768};
          pg8::SchedSsm S{256, G, bid, 1}; pg8::EpiY E{(bf16*)(ws + WS_YG), (const bf16*)(ws + WS_UH), args.in[18]};
          pg8::gemm_phase<pg8::EpiY, pg8::SchedSsm, true, true>(lds, g, S, E); }
        cnt_arrive(cnt + 128);
        ph_attn(args, (char*)lds_raw, bid, G, 4, 6);
        cnt_wait(cnt + 128, (unsigned)G, tmo);
        { pg8::Gemm g{(const bf16*)(ws + WS_YG), (const bf16*)(ws + WS_WGLU), MLAT, DSSM, DSSM, DSSM, DSSM};
          pg8::SchedX S; S.so.init(MLAT, DSSM, G, bid); S.extra = 0; S.xpm0 = 0; S.xpn0 = 0; S.xnn = 1;
          pg8::EpiF<1> E{(bf16*)args.out, ACAT_LD, args.in[20], (const bf16*)(ws + WS_YG), DSSM, nullptr};
          pg8::gemm_phase<pg8::EpiF<1>, pg8::SchedX, true, true>(lds, g, S, E); }
        ph_attn(args, (char*)lds_raw, bid, G, 6, 8); });
    RUN(3, { pg8::Gemm g{(const bf16*)args.out, (const bf16*)(ws + WS_BCAT), MLAT, DM, ACAT_LD, ACAT_LD, ACAT_LD};
        pg8::SchedX S; S.so.init(MLAT, DM, G, bid); S.extra = 0; S.xpm0 = 0; S.xpn0 = 0; S.xnn = 1;
        pg8::EpiMerge E{(bf16*)(ws + WS_MG), (const bf16*)(ws + WS_SGA), (const bf16*)(ws + WS_SGS)};
        pg8::gemm_phase<pg8::EpiMerge, pg8::SchedX, true, true, 8>(lds, g, S, E); });
    RUN(4, { pg8::Gemm g{(const bf16*)(ws + WS_MG), (const bf16*)(ws + WS_WOUT), MLAT, DM, DM, DM, DM};
        pg8::SchedX S; S.so.init(MLAT, DM, G, bid); S.extra = 0; S.xpm0 = 0; S.xpn0 = 0; S.xnn = 1;
        pg8::EpiX1 E{args.in[0], (bf16*)(ws + WS_X1), (bf16*)args.out, (const float*)(ws + WS_MV) + 2048, (const float*)(ws + WS_GM), (float*)(ws + WS_ROWSS), 6144};
        pg8::gemm_phase<pg8::EpiX1, pg8::SchedX, true, true>(lds, g, S, E); });
    RUN(5, { pg8::Gemm g{(const bf16*)args.out, (const bf16*)(ws + WS_W1), MLAT, DFF, DM, DM, DM};
        pg8::SchedX S; S.so.init(MLAT, DFF, G, bid, WGM_M1); S.extra = 0; S.xpm0 = 0; S.xpn0 = 0; S.xnn = 1;
        pg8::EpiMlp1 E{(bf16*)(ws + WS_P), (const float*)(ws + WS_ROWSS), (const float*)(ws + WS_SHB)};
        pg8::gemm_phase<pg8::EpiMlp1, pg8::SchedX, true, true>(lds, g, S, E); });
    RUN(6, { pg8::Gemm g{(const bf16*)(ws + WS_P), (const bf16*)(ws + WS_W2), MLAT, DM, DFF, DFF, DFF};
        pg8::SchedX S; S.so.init(MLAT, DM, G, bid); S.extra = 0; S.xpm0 = 0; S.xpn0 = 0; S.xnn = 1; S.rev = (G == 256) ? 2 : 0;
        pg8::EpiOut E{args.in[0], (const bf16*)(ws + WS_X1), args.out, (const float*)(ws + WS_MV) + 5120, args.in[27], 6144};
        pg8::gemm_phase<pg8::EpiOut, pg8::SchedX, true, true>(lds, g, S, E); });
#undef IN
#undef SEAM
}

#ifndef MK_SPLIT
#define MK_SPLIT 0
#endif
extern "C" void kernel_launch(void* const* d_in, const int* in_sizes, int n_in, void* d_out, int out_size, void* d_ws, size_t ws_size, hipStream_t stream) {
    static int grid = 0;
    if (grid == 0) {
        if (n_in != 28 || out_size != MLAT * DM || ws_size < WS_END) { fprintf(stderr, "kernel_launch: unexpected shapes (n_in %d out %d ws %zu)\n", n_in, out_size, ws_size); grid = -1; return; }
        int dev = 0, cus = 0, per_cu = 0;
        hipGetDevice(&dev); hipDeviceGetAttribute(&cus, hipDeviceAttributeMultiprocessorCount, dev);
        hipFuncSetAttribute((const void*)mega, hipFuncAttributeMaxDynamicSharedMemorySize, LDS_BYTES);
        hipOccupancyMaxActiveBlocksPerMultiprocessor(&per_cu, (const void*)mega, 512, LDS_BYTES);
        (void)hipGetLastError();
        if (per_cu < 1) { fprintf(stderr, "kernel_launch: occupancy query says %d blocks/CU\n", per_cu); per_cu = 1; }
        grid = cus;
        fprintf(stderr, "kernel_launch: grid %d (cus %d, per_cu %d)\n", grid, cus, per_cu);
    }
    if (grid < 0) return;
    hipMemsetAsync((char*)d_ws + WS_CTL, 0, CTL_ZERO_BYTES, stream);
    Args a{};
    for (int i = 0; i < 28; ++i) a.in[i] = (const float*)d_in[i];
    a.out = (float*)d_out; a.ws = (unsigned char*)d_ws;
#if MK_SPLIT
    for (int ph = 0; ph < NPHASE; ++ph) { a.ph_lo = ph; a.ph_hi = ph + 1; a.li = ph; hipLaunchKernelGGL(mega, dim3(grid), dim3(512), LDS_BYTES, stream, a); }
#else
    a.ph_lo = 0; a.ph_hi = NPHASE; a.li = 0;
    hipLaunchKernelGGL(mega, dim3(grid), dim3(512), LDS_BYTES, stream, a);
#endif
}
```

```cpp
#include <hip/hip_runtime.h>
#include <cstdio>
#include <cstdint>
#include <cmath>
namespace pg8 {
#define PG8_LAS __attribute__((address_space(3)))
typedef unsigned short bf16_t;
typedef short bf16x8 __attribute__((ext_vector_type(8)));
typedef float f32x4 __attribute__((ext_vector_type(4)));
typedef unsigned u32x4 __attribute__((ext_vector_type(4)));
constexpr int BM = 256, BK = 64, HALF = 128, HTB = HALF * BK * 2  , STAGE_BYTES = 8 * HTB, NXCD = 8, WGM = 8;

__host__ __device__ __forceinline__ int lds_byte(int r, int c) { const int st = (r >> 4) * 2 + (c >> 5), rr = r & 15, cc = c & 31, ob = rr * 64 + cc * 2; return st * 1024 + (ob ^ (((ob >> 9) & 1) << 5)); }
__host__ __device__ __forceinline__ void stage_rc(int b, int& R, int& C) { const int st = b / 1024, sb = b % 1024, swz = sb ^ (((sb >> 9) & 1) << 5); R = (st >> 1) * 16 + swz / 64; C = (st & 1) * 32 + (swz % 64) / 2; }
__host__ __device__ __forceinline__ int perm32(int rho) { const int n = rho >> 4, i = rho & 15; return 8 * (i >> 2) + 4 * n + (i & 3); }

struct Unit { int pm, pn; };
struct Gemm { const bf16_t* A; const bf16_t* Bt; int M, N, K, lda, ldb; };

struct StaticOrder {
    int nM, nN, nwg, G, c, wgm;
    __host__ __device__ void init(int M, int N, int G_, int c_, int wgm_ = WGM) { nM = M / BM; nN = N / BM; nwg = nM * nN; G = G_; c = c_; wgm = wgm_; }
    __host__ __device__ bool next(int i, Unit& u) const {
        const long L = (long)i * G + c; if (L >= nwg) return false;
        int wgid = (int)L; { const int q = nwg / NXCD, r = nwg % NXCD, xcd = wgid % NXCD, off = wgid / NXCD; wgid = (xcd < r ? xcd * (q + 1) : r * (q + 1) + (xcd - r) * q) + off; }
        const int nig = wgm * nN, gid = wgid / nig, fm = gid * wgm, gsz = (nM - fm) < wgm ? (nM - fm) : wgm;
        u.pm = fm + ((wgid % nig) % gsz); u.pn = (wgid % nig) / gsz; return true;
    }
    __device__ __forceinline__ void a_ready(const Unit&) const {}
    __device__ __forceinline__ void done(const Unit&) const {}
};

__device__ __forceinline__ unsigned cvt_pk_bf16(float lo, float hi) { unsigned r; asm volatile("v_cvt_pk_bf16_f32 %0, %1, %2" : "=v"(r) : "v"(lo), "v"(hi)); return r; }
typedef float f32x2 __attribute__((ext_vector_type(2)));
__device__ __forceinline__ f32x2 gelu_pk(f32x2 v) {
    const f32x2 av = __builtin_elementwise_abs(v), d = av * 0.2316418882f + 1.0f;
    f32x2 t; t.x = __builtin_amdgcn_rcpf(d.x); t.y = __builtin_amdgcn_rcpf(d.y);
    f32x2 q = t * 0.5307027145f + (-0.7265760135f); q = q * t + 0.7107068705f; q = q * t + (-0.142248368f); q = q * t + 0.127414796f; q = q * t;
    const f32x2 s = (v * v) * (-0.72134752044f);
    f32x2 e; e.x = __builtin_amdgcn_exp2f(s.x); e.y = __builtin_amdgcn_exp2f(s.y);
    const f32x2 m = v * (q * e), r = v - m;
    f32x2 o; o.x = v.x < 0.f ? m.x : r.x; o.y = v.y < 0.f ? m.y : r.y; return o;
}

template <int ACT  > struct EpiBf16 {
    static constexpr bool PERM = true, AFTER_DRAIN = false; static_assert(ACT == 0 || ACT == 1, "EpiBf16: ACT is 0 (none) or 1 (gelu_pk)");
    bf16_t* O; int ldc; const float* bias; int split_cols; size_t split_stride; float scale0;
    __device__ __forceinline__ void operator()(const f32x4 (&acc)[2][2][4][2], const Unit& u, int wr, int wc, int fr, int fq) const {
        const int row0 = u.pm * BM + wr * 64 + fr; int colt = u.pn * BM; bf16_t* base = O;
        float sc = 1.f; if (split_cols) { const int t = colt / split_cols; base += (size_t)t * split_stride; colt -= t * split_cols; if (t == 0) sc = scale0; }
        const int col0 = colt + wc * 32 + 8 * fq, bcol0 = u.pn * BM + wc * 32 + 8 * fq;
        f32x4 bv[2][2];
#pragma unroll
        for (int bj = 0; bj < 2; ++bj)
#pragma unroll
            for (int n = 0; n < 2; ++n) bv[bj][n] = bias ? *(const f32x4*)(bias + bcol0 + bj * HALF + 4 * n) : (f32x4){0.f, 0.f, 0.f, 0.f};
#pragma unroll
        for (int ai = 0; ai < 2; ++ai)
#pragma unroll
            for (int m = 0; m < 4; ++m) { bf16_t* rowp = base + (size_t)(row0 + ai * HALF + m * 16) * ldc + col0;
#pragma unroll
                for (int bj = 0; bj < 2; ++bj) { f32x4 v0 = acc[ai][bj][m][0] + bv[bj][0], v1 = acc[ai][bj][m][1] + bv[bj][1];
                    if (ACT == 1) { f32x2 a = gelu_pk((f32x2){v0[0], v0[1]}), b = gelu_pk((f32x2){v0[2], v0[3]}), c = gelu_pk((f32x2){v1[0], v1[1]}), d = gelu_pk((f32x2){v1[2], v1[3]});
                        v0 = (f32x4){a.x, a.y, b.x, b.y}; v1 = (f32x4){c.x, c.y, d.x, d.y}; }
                    v0 = v0 * sc; v1 = v1 * sc; u32x4 w; w.x = cvt_pk_bf16(v0[0], v0[1]); w.y = cvt_pk_bf16(v0[2], v0[3]); w.z = cvt_pk_bf16(v1[0], v1[1]); w.w = cvt_pk_bf16(v1[2], v1[3]);
                    *(u32x4*)(rowp + bj * HALF) = w; } }
    }
};
template <class Epi, class Sched, bool ALIGN_EPI = false, bool SP2 = false, int HOOKT = -1>
__device__ __forceinline__ void gemm_phase(PG8_LAS unsigned char* lds, const Gemm g, const Sched& S, const Epi& E) {
    const int tid = threadIdx.x, wid = __builtin_amdgcn_readfirstlane(tid >> 6), lane = tid & 63, wr = wid >> 2, wc = wid & 3, fr = lane & 15, fq = lane >> 4;
    const int K = g.K, nt = K / BK;
    unsigned voffA[2], voffB[2];
#pragma unroll
    for (int i = 0; i < 2; ++i) { int R, C; stage_rc(tid * 16 + i * 8192, R, C); const int Rb = Epi::PERM ? ((R & ~31) + perm32(R & 31)) : R;
        voffA[i] = (unsigned)(R * g.lda + C) * 2u; voffB[i] = (unsigned)(Rb * g.ldb + C) * 2u; }
    const size_t kstep = (size_t)(BK * 2);
    const size_t hstepA = (size_t)HALF * g.lda * 2, hstepB = (size_t)HALF * g.ldb * 2;
    const size_t tstepA = 2 * hstepA, tstepB = 2 * hstepB;
    const unsigned ldsw = (unsigned)wid * 1024u;
    const int aoff = lds_byte(wr * 64 + fr, fq * 8), boff = lds_byte(wc * 32 + fr, fq * 8);
#define PG8_SA(b, h) (((b) * 2 + (h)) * HTB)
#define PG8_SB(b, h) ((4 + (b) * 2 + (h)) * HTB)
#define PG8_STAGE(bufoff, gbase, voff) do { _Pragma("unroll") for (int _i = 0; _i < 2; ++_i) \
        __builtin_amdgcn_global_load_lds((const unsigned*)((const char*)(gbase) + (voff)[_i]), (PG8_LAS unsigned*)(lds + (bufoff) + ldsw + _i * 8192), 16, 0, 0); } while (0)
#define PG8_LDA(dst, b, h) do { _Pragma("unroll") for (int m = 0; m < 4; ++m) _Pragma("unroll") for (int k = 0; k < 2; ++k) dst[m][k] = *(const PG8_LAS bf16x8*)(lds + PG8_SA(b, h) + aoff + m * 2048 + k * 1024); } while (0)
#define PG8_LDB(dst, b, h) do { _Pragma("unroll") for (int n = 0; n < 2; ++n) _Pragma("unroll") for (int k = 0; k < 2; ++k) dst[n][k] = *(const PG8_LAS bf16x8*)(lds + PG8_SB(b, h) + boff + n * 2048 + k * 1024); } while (0)
#define PG8_MMA(ai, bj, At, Bt) do { __builtin_amdgcn_s_setprio(1); _Pragma("unroll") for (int m = 0; m < 4; ++m) _Pragma("unroll") for (int n = 0; n < 2; ++n) _Pragma("unroll") for (int k = 0; k < 2; ++k) \
        acc[ai][bj][m][n] = __builtin_amdgcn_mfma_f32_16x16x32_bf16(Bt[n][k], At[m][k], acc[ai][bj][m][n], 0, 0, 0); __builtin_amdgcn_s_setprio(0); } while (0)
#define PG8_WAIT_V(n) asm volatile("s_waitcnt vmcnt(" #n ")" ::: "memory")
#define PG8_WAIT_L(n) asm volatile("s_waitcnt lgkmcnt(" #n ")" ::: "memory")
#define PG8_BAR __builtin_amdgcn_s_barrier()
#define PG8_SCHED __builtin_amdgcn_sched_barrier(0)
    Unit cur, nxt; int ui = 0;
    if (!S.next(0, cur)) return;
    f32x4 acc[2][2][4][2];
#pragma unroll
    for (int a = 0; a < 2; ++a)
#pragma unroll
        for (int b = 0; b < 2; ++b)
#pragma unroll
            for (int m = 0; m < 4; ++m)
#pragma unroll
                for (int n = 0; n < 2; ++n) acc[a][b][m][n] = (f32x4){0.f, 0.f, 0.f, 0.f};
    bf16x8 At[4][2], B0[2][2], B1[2][2];
    const char* cA = (const char*)g.A + (size_t)cur.pm * tstepA; const char* cB = (const char*)g.Bt + (size_t)cur.pn * tstepB;
    S.a_ready(cur);
    if constexpr (SP2) {
        PG8_STAGE(PG8_SB(0, 0), cB, voffB); PG8_STAGE(PG8_SB(0, 1), cB + hstepB, voffB); PG8_STAGE(PG8_SA(0, 0), cA, voffA); PG8_STAGE(PG8_SA(0, 1), cA + hstepA, voffA);
        if (wr == 1) PG8_BAR;
        PG8_WAIT_V(2); PG8_BAR;
        PG8_STAGE(PG8_SB(1, 0), cB + kstep, voffB); PG8_STAGE(PG8_SA(1, 0), cA + kstep, voffA); PG8_STAGE(PG8_SB(1, 1), cB + hstepB + kstep, voffB);
        PG8_WAIT_V(6); PG8_BAR;
    } else {
        PG8_STAGE(PG8_SB(0, 0), cB, voffB); PG8_STAGE(PG8_SA(0, 0), cA, voffA); PG8_STAGE(PG8_SB(0, 1), cB + hstepB, voffB); PG8_STAGE(PG8_SA(0, 1), cA + hstepA, voffA);
        if (wr == 1) PG8_BAR;
        PG8_WAIT_V(4); PG8_BAR;
        PG8_STAGE(PG8_SB(1, 0), cB + kstep, voffB); PG8_STAGE(PG8_SA(1, 0), cA + kstep, voffA); PG8_STAGE(PG8_SB(1, 1), cB + hstepB + kstep, voffB);
        PG8_WAIT_V(6); PG8_BAR;
    }
    for (;;) {
        const bool has_next = S.next(ui + 1, nxt);
        const char* nA = has_next ? (const char*)g.A + (size_t)nxt.pm * tstepA : cA; const char* nB = has_next ? (const char*)g.Bt + (size_t)nxt.pn * tstepB : cB;
        for (int tseg = 0; tseg < nt; ) { const int tend = (HOOKT >= 0 && tseg < HOOKT) ? HOOKT : nt;
#pragma nounroll
        for (int t = tseg; t < tend; t += 2) {
            const bool last = (t == nt - 2);
            const char* a1 = cA + (size_t)(t + 1) * kstep;
            const char* a2 = last ? nA : cA + (size_t)(t + 2) * kstep; const char* b2 = last ? nB : cB + (size_t)(t + 2) * kstep;
            const char* a3 = a2 + kstep; const char* b3 = b2 + kstep;
            if (last && has_next) S.a_ready(nxt);
            if constexpr (SP2) {
            PG8_LDB(B0, 0, 0); PG8_LDB(B1, 0, 1); PG8_SCHED; PG8_LDA(At, 0, 0); PG8_STAGE(PG8_SA(1, 1), a1 + hstepA, voffA);
            PG8_WAIT_V(8); PG8_WAIT_L(0); PG8_BAR; PG8_MMA(0, 0, At, B0); PG8_MMA(0, 1, At, B1); PG8_BAR; PG8_SCHED;
            PG8_LDA(At, 0, 1); PG8_STAGE(PG8_SB(0, 0), b2, voffB); PG8_STAGE(PG8_SB(0, 1), b2 + hstepB, voffB); PG8_STAGE(PG8_SA(0, 0), a2, voffA);
            PG8_WAIT_V(8); PG8_WAIT_L(0); PG8_BAR; PG8_MMA(1, 0, At, B0); PG8_MMA(1, 1, At, B1); PG8_BAR; PG8_SCHED;
            PG8_LDB(B0, 1, 0); PG8_LDB(B1, 1, 1); PG8_SCHED; PG8_LDA(At, 1, 0); PG8_STAGE(PG8_SA(0, 1), a2 + hstepA, voffA);
            PG8_WAIT_V(8); PG8_WAIT_L(0); PG8_BAR; PG8_MMA(0, 0, At, B0); PG8_MMA(0, 1, At, B1); PG8_BAR; PG8_SCHED;
            PG8_LDA(At, 1, 1); PG8_STAGE(PG8_SB(1, 0), b3, voffB); PG8_STAGE(PG8_SB(1, 1), b3 + hstepB, voffB); PG8_STAGE(PG8_SA(1, 0), a3, voffA);
            PG8_WAIT_V(8); PG8_WAIT_L(0); PG8_BAR; PG8_MMA(1, 0, At, B0); PG8_MMA(1, 1, At, B1); PG8_BAR; PG8_SCHED;
            } else {
            PG8_LDB(B0, 0, 0); PG8_SCHED; PG8_LDA(At, 0, 0); PG8_STAGE(PG8_SA(1, 1), a1 + hstepA, voffA);
            PG8_WAIT_L(8); PG8_BAR; PG8_WAIT_L(0); PG8_MMA(0, 0, At, B0); PG8_BAR; PG8_SCHED;
            PG8_LDB(B1, 0, 1); PG8_STAGE(PG8_SB(0, 0), b2, voffB);
            PG8_BAR; PG8_WAIT_L(0); PG8_MMA(0, 1, At, B1); PG8_BAR;
            PG8_LDA(At, 0, 1); PG8_STAGE(PG8_SA(0, 0), a2, voffA);
            PG8_BAR; PG8_WAIT_L(0); PG8_MMA(1, 0, At, B0); PG8_BAR; PG8_SCHED;
            PG8_STAGE(PG8_SB(0, 1), b2 + hstepB, voffB);
            PG8_WAIT_V(6); PG8_BAR; PG8_MMA(1, 1, At, B1); PG8_BAR;
            PG8_LDB(B0, 1, 0); PG8_SCHED; PG8_LDA(At, 1, 0); PG8_STAGE(PG8_SA(0, 1), a2 + hstepA, voffA);
            PG8_WAIT_L(8); PG8_BAR; PG8_WAIT_L(0); PG8_MMA(0, 0, At, B0); PG8_BAR; PG8_SCHED;
            PG8_LDB(B1, 1, 1); PG8_STAGE(PG8_SB(1, 0), b3, voffB);
            PG8_BAR; PG8_WAIT_L(0); PG8_MMA(0, 1, At, B1); PG8_BAR;
            PG8_LDA(At, 1, 1); PG8_STAGE(PG8_SA(1, 0), a3, voffA);
            PG8_BAR; PG8_WAIT_L(0); PG8_MMA(1, 0, At, B0); PG8_BAR; PG8_SCHED;
            PG8_STAGE(PG8_SB(1, 1), b3 + hstepB, voffB);
            PG8_WAIT_V(6); PG8_BAR; PG8_MMA(1, 1, At, B1); PG8_BAR;
            }
        }
        if constexpr (HOOKT >= 0) { if (tend != nt) E.mid(acc, cur, wr, wc, fr, fq); }
        tseg = tend; }
        if constexpr (ALIGN_EPI) { if (wr == 0) PG8_BAR; }
        if constexpr (!Epi::AFTER_DRAIN) { E(acc, cur, wr, wc, fr, fq); S.done(cur); }
        if (!has_next) break;
#pragma unroll
        for (int a = 0; a < 2; ++a)
#pragma unroll
            for (int b = 0; b < 2; ++b)
#pragma unroll
                for (int m = 0; m < 4; ++m)
#pragma unroll
                    for (int n = 0; n < 2; ++n) acc[a][b][m][n] = (f32x4){0.f, 0.f, 0.f, 0.f};
        cur = nxt; cA = nA; cB = nB; ++ui;
        if constexpr (ALIGN_EPI) { if (wr == 1) PG8_BAR; }
    }
    PG8_WAIT_V(0);
    if constexpr (!ALIGN_EPI) { if (wr == 0) PG8_BAR; }
    PG8_BAR;
    if constexpr (Epi::AFTER_DRAIN) { E.fused(acc, cur, wr, wc, fr, fq, lds, wid, lane); S.done(cur); }
#undef PG8_SA
#undef PG8_SB
#undef PG8_STAGE
#undef PG8_LDA
#undef PG8_LDB
#undef PG8_MMA
#undef PG8_WAIT_V
#undef PG8_WAIT_L
#undef PG8_BAR
#undef PG8_SCHED
}
}
#include <hip/hip_bf16.h>
#include <cmath>
namespace attn_body {
using bf16=__hip_bfloat16;
using bf16x8=__attribute__((ext_vector_type(8)))short;
using s16x4=__attribute__((ext_vector_type(4)))short;
using f32x16=__attribute__((ext_vector_type(16)))float;
using u32x4=__attribute__((ext_vector_type(4)))unsigned;
constexpr int NHEAD=16,SEQ=2048,D=64;
constexpr int NKT=36, NKT_LAT=32;
constexpr int NW=8,QBLK=32,QB=QBLK*NW,KVBLK=64,NQB=SEQ/QB;
constexpr int ATTN_UNIT_ROWS=QB;
__device__ __forceinline__ int crow(int r,int hi){return (r&3)+8*(r>>2)+4*hi;}
#define SBAR() __builtin_amdgcn_sched_barrier(0)
__device__ __forceinline__ void cmask(f32x16&p0,f32x16&p1,int jb,int qrel,int hi){
  const float NEG=-INFINITY; int kb=64*jb+4*hi;
  #pragma unroll
  for(int r=0;r<16;++r){int kv=kb+(r&3)+8*(r>>2); if(kv>qrel)p0[r]=NEG; if(kv+32>qrel)p1[r]=NEG;}
}

constexpr int NSLOT=3, SLOTB=8192;
constexpr int LDS_K=0, LDS_V=NSLOT*SLOTB, LDS_WS=2*NSLOT*SLOTB, LDS_OST=LDS_WS+NW*64*4, LDS_BYTES=LDS_OST+NW*4096;
constexpr float C2=0.125f*1.4426950408889634f;
__device__ __forceinline__ void glds16(const void*gsrc,unsigned lds_dst){unsigned keep;
  asm volatile("s_mov_b32 %0, m0\n\ts_mov_b32 m0, %2\n\ts_nop 0\n\tglobal_load_lds_dwordx4 %1, off\n\ts_mov_b32 m0, %0":"=&s"(keep):"v"(gsrc),"s"(lds_dst):"memory");}
__device__ __forceinline__ float max3f(float a,float b,float c){float r;asm("v_max3_f32 %0, %1, %2, %3":"=v"(r):"v"(a),"v"(b),"v"(c));return r;}
__device__ __forceinline__ float max2f(float a,float b){float r;asm("v_max_f32_e32 %0, %1, %2":"=v"(r):"v"(a),"v"(b));return r;}
__device__ __forceinline__ float fadd_s(float a,float b){float r;asm("v_add_f32_e32 %0, %1, %2":"=v"(r):"v"(a),"v"(b));return r;}
__device__ __forceinline__ float fsub_s(float a,float b){float r;asm("v_sub_f32_e32 %0, %1, %2":"=v"(r):"v"(a),"v"(b));return r;}
typedef float f32x2_t __attribute__((ext_vector_type(2))); typedef __bf16 bf16x2_t __attribute__((ext_vector_type(2)));
__device__ __forceinline__ unsigned cvtpk_s(float lo,float hi){f32x2_t v={lo,hi};bf16x2_t b=__builtin_convertvector(v,bf16x2_t);return __builtin_bit_cast(unsigned,b);}
#define WAIT_BAR(N) asm volatile("s_waitcnt vmcnt(" #N ") lgkmcnt(0)\n\ts_barrier":::"memory")

__device__ __forceinline__ void qkt(f32x16&p0,f32x16&p1,const char*Kslot,const bf16x8*qr,const f32x16&negm,int r32,int hi){
  const char*kb=Kslot+hi*1024+r32*16;
  #pragma unroll
  for(int d0=0;d0<4;++d0){
    const bf16x8 b0=*reinterpret_cast<const bf16x8*>(kb+d0*2048);
    const bf16x8 b1=*reinterpret_cast<const bf16x8*>(kb+d0*2048+512);
    if(d0==0){p0=__builtin_amdgcn_mfma_f32_32x32x16_bf16(b0,qr[0],negm,0,0,0);p1=__builtin_amdgcn_mfma_f32_32x32x16_bf16(b1,qr[0],negm,0,0,0);}
    else{p0=__builtin_amdgcn_mfma_f32_32x32x16_bf16(b0,qr[d0],p0,0,0,0);p1=__builtin_amdgcn_mfma_f32_32x32x16_bf16(b1,qr[d0],p1,0,0,0);}}
}
typedef __attribute__((address_space(3))) const char* lds_cptr;
typedef short v4i16_t __attribute__((ext_vector_type(4)));
__device__ __forceinline__ void kload8(bf16x8*kf,lds_cptr kp){
  kf[0]=*(const __attribute__((address_space(3))) bf16x8*)(kp);      kf[1]=*(const __attribute__((address_space(3))) bf16x8*)(kp+512);
  kf[2]=*(const __attribute__((address_space(3))) bf16x8*)(kp+2048); kf[3]=*(const __attribute__((address_space(3))) bf16x8*)(kp+2560);
  kf[4]=*(const __attribute__((address_space(3))) bf16x8*)(kp+4096); kf[5]=*(const __attribute__((address_space(3))) bf16x8*)(kp+4608);
  kf[6]=*(const __attribute__((address_space(3))) bf16x8*)(kp+6144); kf[7]=*(const __attribute__((address_space(3))) bf16x8*)(kp+6656);
}
__device__ __forceinline__ void kload2(bf16x8*kf,lds_cptr kp,int j){ kf[2*j]=*(const __attribute__((address_space(3))) bf16x8*)(kp+j*2048); kf[2*j+1]=*(const __attribute__((address_space(3))) bf16x8*)(kp+j*2048+512); }
__device__ __forceinline__ s16x4 vtr(lds_cptr p){ return __builtin_bit_cast(s16x4,__builtin_amdgcn_ds_read_tr16_b64_v4i16((__attribute__((address_space(3))) v4i16_t*)p)); }
__device__ __forceinline__ float rowmax(const f32x16&p0,const f32x16&p1){
  float a=max3f(p0[0],p0[1],p1[0]),b=max3f(p0[2],p0[3],p1[1]);a=max3f(a,p1[2],p1[3]);
  #pragma unroll
  for(int r=4;r<16;r+=4){a=max3f(a,p0[r],p0[r+1]);b=max3f(b,p0[r+2],p0[r+3]);a=max3f(a,p1[r],p1[r+1]);b=max3f(b,p1[r+2],p1[r+3]);}
  const float m=max2f(a,b);
  auto rr=__builtin_amdgcn_permlane32_swap(__float_as_uint(m),__float_as_uint(m),false,false);
  return max2f(__uint_as_float(rr[0]),__uint_as_float(rr[1]));
}
__device__ __forceinline__ void pv(f32x16*o,int vb,bf16x8 pa0,bf16x8 pa1,bf16x8 pa2,bf16x8 pa3){
  #pragma unroll
  for(int d0=0;d0<2;++d0){s16x4 lo[4],hi[4];
    #pragma unroll
    for(int ks=0;ks<4;++ks){
      asm volatile("ds_read_b64_tr_b16 %0,%1 offset:%c2":"=&v"(lo[ks]):"v"(vb),"i"(d0*4096+ks*1024):"memory");
      asm volatile("ds_read_b64_tr_b16 %0,%1 offset:%c2":"=&v"(hi[ks]):"v"(vb),"i"(d0*4096+ks*1024+512):"memory");}
    asm volatile("s_waitcnt lgkmcnt(0)":::"memory");SBAR();
    #define PK(k) (bf16x8){lo[k][0],lo[k][1],lo[k][2],lo[k][3],hi[k][0],hi[k][1],hi[k][2],hi[k][3]}
    o[d0]=__builtin_amdgcn_mfma_f32_32x32x16_bf16(pa0,PK(0),o[d0],0,0,0);
    o[d0]=__builtin_amdgcn_mfma_f32_32x32x16_bf16(pa1,PK(1),o[d0],0,0,0);
    o[d0]=__builtin_amdgcn_mfma_f32_32x32x16_bf16(pa2,PK(2),o[d0],0,0,0);
    o[d0]=__builtin_amdgcn_mfma_f32_32x32x16_bf16(pa3,PK(3),o[d0],0,0,0);
    #undef PK
  }
}

#ifndef ATTN_STORE16
#define ATTN_STORE16(p,v) (*(u32x4*)(p)=(v))
#endif
template<int THRL,int QP,int KVP,int OP> __device__ __forceinline__ void attn_unit(int h,int qb,const bf16*Qb,const bf16*Kl,const bf16*Vl,const bf16*Kc,const bf16*Vc,bf16*Ob,char*shm){
  int tid=threadIdx.x; asm volatile("":"+v"(tid));
  const int lane=tid&63,r32=lane&31,hi=lane>>5; const int wid=__builtin_amdgcn_readfirstlane(tid>>6);
  const int q0=qb*QB;
  const bf16*Qw=Qb+(long)(q0+wid*QBLK)*QP+h*D;
  const int kvh=h>>2; const bf16*Kh=Kl+kvh*D,*Vh=Vl+kvh*D; const long cdk=(Kc-Kl)-(long)NKT_LAT*KVBLK*KVP, cdv=(Vc-Vl)-(long)NKT_LAT*KVBLK*KVP;
  const unsigned lds0=(unsigned)(uintptr_t)shm;
  float*wsf=(float*)(shm+LDS_WS)+wid*64;
  const bf16*ksrc=Kh+(long)lane*KVP+wid*8;
  const bf16*vsrc=Vh+(long)(16*(wid&3)+(lane>>2))*KVP+(wid>>2)*32+(lane&3)*8;
  const unsigned kdst=lds0+LDS_K+wid*1024, vdst=lds0+LDS_V+wid*1024;
  #define DMA_K(t,slot) glds16(ksrc+(long)(t)*KVBLK*KVP+(((t)>=NKT_LAT)?cdk:0l),(unsigned)__builtin_amdgcn_readfirstlane(kdst+(slot)))
  #define DMA_V(t,slot) glds16(vsrc+(long)(t)*KVBLK*KVP+(((t)>=NKT_LAT)?cdv:0l),(unsigned)__builtin_amdgcn_readfirstlane(vdst+(slot)))
  const int vb0=(int)(lds0+LDS_V)+((lane>>4)&1)*32+(lane&3)*8+(4*hi+((lane&15)>>2))*64;
  const char*Kbase=shm+LDS_K; bf16x8 kf[8];
  const lds_cptr shm3=(lds_cptr)shm; const lds_cptr kp0=shm3+LDS_K+hi*1024+r32*16; const lds_cptr vp0=shm3+LDS_V+((lane>>4)&1)*32+(lane&3)*8+(4*hi+((lane&15)>>2))*64;
  constexpr int NT=NKT;
  DMA_K(0,0);DMA_V(0,0);DMA_K(1,SLOTB);
  bf16x8 qr[4];
  #pragma unroll
  for(int d0=0;d0<4;++d0)qr[d0]=*reinterpret_cast<const bf16x8*>(&Qw[(long)r32*QP+d0*16+hi*8]);
  float mhat=0.f,l_reg=0.f;f32x16 o[2];o[0]=f32x16{};o[1]=f32x16{};f32x16 negm=f32x16{};asm volatile("":"+v"(negm));
  #define CMASK(P0,P1,t) do{}while(0)
  bool resc=false;
  #define START(P0,P1) do{ const float rm=rowmax(P0,P1); resc=false; \
    { const float dl=rm; mhat=fadd_s(mhat,dl); \
      _Pragma("unroll") for(int r=0;r<16;++r){P0[r]=fsub_s(P0[r],dl);P1[r]=fsub_s(P1[r],dl);} \
      _Pragma("unroll") for(int r=0;r<16;++r)negm[r]=-mhat; asm volatile("":"+v"(negm)); } \
    _Pragma("unroll") for(int r=0;r<16;++r)P0[r]=__builtin_amdgcn_exp2f(P0[r]); }while(0)
  #define RESC() do{ if(resc){ asm volatile("s_waitcnt lgkmcnt(0)":::"memory"); \
      _Pragma("unroll") for(int d_=0;d_<2;++d_) _Pragma("unroll") for(int r=0;r<16;++r)o[d_][r]*=wsf[crow(r,hi)]; } }while(0)
  f32x16 pA0,pA1,pB0,pB1;
  int sl_prev=0,sl_cur=0,sl_next=SLOTB;
  #define ROT() do{sl_prev=sl_cur;sl_cur=sl_next;sl_next=(sl_next==(NSLOT-1)*SLOTB)?0:sl_next+SLOTB;}while(0)
  DMA_K(2,2*SLOTB);
  WAIT_BAR(3);
  qkt(pA0,pA1,Kbase,qr,negm,r32,hi);asm volatile("s_nop 15\n\ts_nop 7":"+v"(pA0),"+v"(pA1));CMASK(pA0,pA1,0);
  START(pA0,pA1);
  _Pragma("unroll") for(int r=0;r<16;++r)pA1[r]=__builtin_amdgcn_exp2f(pA1[r]);
  WAIT_BAR(0);
  DMA_K(3,0);DMA_V(1,SLOTB);
  ROT();
  kload8(kf,kp0+sl_cur);
  WAIT_BAR(2);
  s16x4 vlo[8],vhi[8]; u32x4 pw0,pw1,pw2,pw3;
  #define PKW(P,B) cvtpk_s(P[B],P[B+1])
  #define PAF(k) __builtin_bit_cast(bf16x8,pw##k)
  #define VFR(i) (bf16x8){vlo[i][0],vlo[i][1],vlo[i][2],vlo[i][3],vhi[i][0],vhi[i][1],vhi[i][2],vhi[i][3]}
  #define PIN(x) asm volatile("":"+v"(x))
  #define MX3(a,b,c) __builtin_fmaxf(__builtin_fmaxf((a),(b)),(c))
  #define GAPA(MF,A0,A1,A2,A3,W0,W1,PW) do{ MF; sacc+=A0; sacc+=A1; sacc+=A2; sacc+=A3; PIN(sacc); W0; W1; PIN(PW); SBAR(); }while(0)
  #define EX(v) __builtin_amdgcn_exp2f(v)
  #define GAPB(MF,X,B) do{ MF; X[B]=EX(X[B]); X[B+1]=EX(X[B+1]); X[B+2]=EX(X[B+2]); X[B+3]=EX(X[B+3]); PIN(X); SBAR(); }while(0)
  #define VRD(i) do{ vlo[i]=vtr(vp_+(((i)>>2)*4096+((i)&3)*1024)); vhi[i]=vtr(vp_+(((i)>>2)*4096+((i)&3)*1024+512)); }while(0)
  #define KRD(G,j) do{ if(G){ kload2(kf,kp0+sl_next,j); SBAR(); } }while(0)
  #define STEP(C0,C1,P0,P1,t,GK,GV,GL) do{ SBAR(); \
    const lds_cptr vp_=vp0+sl_prev; \
    VRD(0); SBAR(); float sacc=(P0[0]+P0[1]); \
    GAPA(C0=__builtin_amdgcn_mfma_f32_32x32x16_bf16(kf[0],qr[0],negm,0,0,0), P0[2],P0[3],P0[4],P0[5],     pw0[0]=PKW(P0,0), pw0[1]=PKW(P0,2), pw0); \
    VRD(4); SBAR(); GAPA(C1=__builtin_amdgcn_mfma_f32_32x32x16_bf16(kf[1],qr[0],negm,0,0,0), P0[6],P0[7],P0[8],P0[9],     pw0[2]=PKW(P0,4), pw0[3]=PKW(P0,6), pw0); \
    VRD(1); SBAR(); GAPA(C0=__builtin_amdgcn_mfma_f32_32x32x16_bf16(kf[2],qr[1],C0,0,0,0),   P0[10],P0[11],P0[12],P0[13], pw1[0]=PKW(P0,8), pw1[1]=PKW(P0,10), pw1); \
    VRD(5); SBAR(); GAPA(C1=__builtin_amdgcn_mfma_f32_32x32x16_bf16(kf[3],qr[1],C1,0,0,0),   P0[14],P0[15],P1[0],P1[1],   pw1[2]=PKW(P0,12),pw1[3]=PKW(P0,14), pw1); \
    VRD(2); SBAR(); GAPA(C0=__builtin_amdgcn_mfma_f32_32x32x16_bf16(kf[4],qr[2],C0,0,0,0),   P1[2],P1[3],P1[4],P1[5],     pw2[0]=PKW(P1,0), pw2[1]=PKW(P1,2), pw2); \
    VRD(6); SBAR(); GAPA(C1=__builtin_amdgcn_mfma_f32_32x32x16_bf16(kf[5],qr[2],C1,0,0,0),   P1[6],P1[7],P1[8],P1[9],     pw2[2]=PKW(P1,4), pw2[3]=PKW(P1,6), pw2); \
    VRD(3); SBAR(); GAPA(C0=__builtin_amdgcn_mfma_f32_32x32x16_bf16(kf[6],qr[3],C0,0,0,0),   P1[10],P1[11],P1[12],P1[13], pw3[0]=PKW(P1,8), pw3[1]=PKW(P1,10), pw3); \
    VRD(7); SBAR(); GAPA(C1=__builtin_amdgcn_mfma_f32_32x32x16_bf16(kf[7],qr[3],C1,0,0,0),   P1[14],P1[15],0.f,0.f,       pw3[2]=PKW(P1,12),pw3[3]=PKW(P1,14), pw3); \
    l_reg+=sacc; \
    if(GK){DMA_K((t)+3,sl_cur);} if(GV){DMA_V((t)+1,sl_next);} \
    CMASK(C0,C1,t); \
    { float a=MX3(C0[0],C0[1],C1[0]),b=MX3(C0[2],C0[3],C1[1]); a=MX3(a,C1[2],C1[3]); \
      _Pragma("unroll") for(int r=4;r<16;r+=4){a=MX3(a,C0[r],C0[r+1]);b=MX3(b,C0[r+2],C0[r+3]);a=MX3(a,C1[r],C1[r+1]);b=MX3(b,C1[r+2],C1[r+3]);} \
      float rm=__builtin_fmaxf(a,b); { auto rr=__builtin_amdgcn_permlane32_swap(__float_as_uint(rm),__float_as_uint(rm),false,false); rm=__builtin_fmaxf(__uint_as_float(rr[0]),__uint_as_float(rr[1])); } \
      resc=false; \
      if(__builtin_expect(__any(rm>(float)THRL),0)){ const float dl=__builtin_fmaxf(rm,0.f); mhat+=dl; \
        _Pragma("unroll") for(int r=0;r<16;++r){C0[r]-=dl;C1[r]-=dl;} \
        _Pragma("unroll") for(int r=0;r<16;++r)negm[r]=-mhat; asm volatile("":"+v"(negm)); \
        const float f=__builtin_amdgcn_exp2f(-dl); l_reg*=f; if(hi==0)wsf[r32]=f; resc=true; } } \
    SBAR(); \
    GAPB(o[0]=__builtin_amdgcn_mfma_f32_32x32x16_bf16(PAF(0),VFR(0),o[0],0,0,0), C0,0); \
    GAPB(o[1]=__builtin_amdgcn_mfma_f32_32x32x16_bf16(PAF(0),VFR(4),o[1],0,0,0), C0,4); \
    KRD(GL,0); GAPB(o[0]=__builtin_amdgcn_mfma_f32_32x32x16_bf16(PAF(1),VFR(1),o[0],0,0,0), C0,8); \
    KRD(GL,1); GAPB(o[1]=__builtin_amdgcn_mfma_f32_32x32x16_bf16(PAF(1),VFR(5),o[1],0,0,0), C0,12); \
    KRD(GL,2); GAPB(o[0]=__builtin_amdgcn_mfma_f32_32x32x16_bf16(PAF(2),VFR(2),o[0],0,0,0), C1,0); \
    KRD(GL,3); GAPB(o[1]=__builtin_amdgcn_mfma_f32_32x32x16_bf16(PAF(2),VFR(6),o[1],0,0,0), C1,4); \
    GAPB(o[0]=__builtin_amdgcn_mfma_f32_32x32x16_bf16(PAF(3),VFR(3),o[0],0,0,0), C1,8); \
    GAPB(o[1]=__builtin_amdgcn_mfma_f32_32x32x16_bf16(PAF(3),VFR(7),o[1],0,0,0), C1,12); \
    }while(0)
  int t=1;
  #undef CMASK
  #define CMASK(P0,P1,t) do{}while(0)
  for(;t+5<NT;t+=2){
    STEP(pB0,pB1,pA0,pA1,t,true,true,true);     WAIT_BAR(2); RESC(); ROT();
    STEP(pA0,pA1,pB0,pB1,t+1,true,true,true);   WAIT_BAR(2); RESC(); ROT();
  }
  #undef CMASK
  #define CMASK(P0,P1,t) do{}while(0)
  #define ENDW(tt) do{ if((tt)+3<NT){WAIT_BAR(2);} else if((tt)+2<NT){WAIT_BAR(1);} else {WAIT_BAR(0);} }while(0)
  for(;t+1<NT;t+=2){
    STEP(pB0,pB1,pA0,pA1,t,(t+3<NT),(t+1<NT),(t+1<NT));       ENDW(t);   RESC(); ROT();
    STEP(pA0,pA1,pB0,pB1,t+1,(t+4<NT),(t+2<NT),(t+2<NT));     ENDW(t+1); RESC(); ROT();
  }
  STEP(pB0,pB1,pA0,pA1,NT-1,false,false,false); RESC();
  { float sacc=pB0[0]+pB0[1]; _Pragma("unroll") for(int r=2;r<16;++r)sacc+=pB0[r]; _Pragma("unroll") for(int r=0;r<16;++r)sacc+=pB1[r]; l_reg+=sacc;
    pw0=(u32x4){PKW(pB0,0),PKW(pB0,2),PKW(pB0,4),PKW(pB0,6)};pw1=(u32x4){PKW(pB0,8),PKW(pB0,10),PKW(pB0,12),PKW(pB0,14)};pw2=(u32x4){PKW(pB1,0),PKW(pB1,2),PKW(pB1,4),PKW(pB1,6)};pw3=(u32x4){PKW(pB1,8),PKW(pB1,10),PKW(pB1,12),PKW(pB1,14)};
    SBAR(); pv(o,vb0+sl_cur,PAF(0),PAF(1),PAF(2),PAF(3)); }
  #undef PKW
  #undef PAF
  #undef VFR
  #undef PIN
  #undef MX3
  #undef GAPA
  #undef GAPB
  #undef EX
  #undef VRD
  #undef KRD
  #undef STEP
  #undef ENDW
  {auto rr=__builtin_amdgcn_permlane32_swap(__float_as_uint(l_reg),__float_as_uint(l_reg),false,false);l_reg=__uint_as_float(rr[0])+__uint_as_float(rr[1]);}
  if(hi==0)wsf[32+r32]=l_reg;asm volatile("s_waitcnt lgkmcnt(0)":::"memory");
  float rli[16];
  #pragma unroll
  for(int r=0;r<16;++r)rli[r]=__builtin_amdgcn_rcpf(wsf[32+crow(r,hi)]);
  bf16*Ow=Ob+(long)(q0+wid*QBLK)*OP+h*D;
  { bf16*stg=(bf16*)(shm+LDS_OST)+wid*2048;
    #pragma unroll
    for(int r=0;r<16;++r){const int orow=crow(r,hi);
      #pragma unroll
      for(int d0=0;d0<2;++d0)stg[orow*64+d0*32+r32]=__float2bfloat16(o[d0][r]*rli[r]);}
    asm volatile("s_waitcnt lgkmcnt(0)":::"memory");
    #pragma unroll
    for(int i=0;i<4;++i){const int row=i*8+(lane>>3),ch=lane&7; const u32x4 v=*(const u32x4*)(stg+row*64+ch*8); ATTN_STORE16(Ow+(long)row*OP+ch*8,v);} }
  asm volatile("s_waitcnt lgkmcnt(0)\n\ts_barrier":::"memory");
  #undef DMA_K
  #undef DMA_V
  #undef CMASK
  #undef START
  #undef RESC
  #undef ROT
}
constexpr int ATTN_LDS_BYTES=LDS_BYTES;
#undef SBAR
#undef WAIT_BAR
}

namespace pg8 {
struct SchedX {
    StaticOrder so; int extra, xpm0, xpn0, xnn; int rev = 0;
    __device__ bool next(int i, Unit& u) const {
        if (rev) { if (i >= rev) return false; return so.next(rev - 1 - i, u); }
        const long L = (long)i * so.G + so.c;
        if (L < so.nwg) return so.next(i, u);
        const int r = (int)(L - so.nwg); if (r >= extra) return false;
        u.pm = xpm0 + r / xnn; u.pn = xpn0 + r % xnn; return true;
    }
    __device__ __forceinline__ void a_ready(const Unit&) const {}
    __device__ __forceinline__ void done(const Unit&) const {}
};

struct SchedSsm {
    int total, G, c, mode;
    __device__ bool next(int i, Unit& u) const {
        const int L = i * G + c; if (L >= total) return false;
        if (mode == 0) { const int g = L / 5; u.pm = L; u.pn = g; }
        else { const int g = L >> 3; u.pm = g * 5 + ((L >> 1) & 3); u.pn = g * 2 + (L & 1); }
        return true;
    }
    __device__ __forceinline__ void a_ready(const Unit&) const {}
    __device__ __forceinline__ void done(const Unit&) const {}
};
struct EpiS {
    static constexpr bool PERM = true, AFTER_DRAIN = false;
    float* S;
    __device__ __forceinline__ void operator()(const f32x4 (&acc)[2][2][4][2], const Unit& u, int wr, int wc, int fr, int fq) const {
        const int row0 = u.pm * BM + wr * 64 + fr; const int col0 = wc * 32 + 8 * fq;
#pragma unroll
        for (int ai = 0; ai < 2; ++ai)
#pragma unroll
            for (int m = 0; m < 4; ++m) { float* rowp = S + (size_t)(row0 + ai * HALF + m * 16) * 256 + col0;
#pragma unroll
                for (int bj = 0; bj < 2; ++bj) { *(f32x4*)(rowp + bj * HALF) = acc[ai][bj][m][0]; *(f32x4*)(rowp + bj * HALF + 4) = acc[ai][bj][m][1]; } }
    }
};
__device__ __forceinline__ float gelu_tanh_(float x) { const float t = x * (-2.302208198f - 0.10294324f * x * x); return x * __builtin_amdgcn_rcpf(1.0f + __builtin_amdgcn_exp2f(t)); }
struct EpiY {
    static constexpr bool PERM = true, AFTER_DRAIN = false;
    bf16_t* YG; const bf16_t* UH; const float* dd;
    __device__ __forceinline__ void operator()(const f32x4 (&acc)[2][2][4][2], const Unit& u, int wr, int wc, int fr, int fq) const {
        const int g = u.pm / 5, pmq = u.pm - 5 * g, pnq = u.pn - 2 * g;
        const int h0 = 8 * (fq & 1);
        const f32x4 d0 = *(const f32x4*)(dd + g * 16 + h0), d1 = *(const f32x4*)(dd + g * 16 + h0 + 4);
#pragma unroll
        for (int ai = 0; ai < 2; ++ai)
#pragma unroll
            for (int m = 0; m < 4; ++m) { const int n = pmq * BM + ai * HALF + wr * 64 + m * 16 + fr;
#pragma unroll
                for (int bj = 0; bj < 2; ++bj) { const int t = (pnq * BM + bj * HALF + wc * 32 + 8 * fq) >> 4;
                    const u32x4 uw = *(const u32x4*)(UH + ((size_t)(g * 1280 + n)) * 768 + t * 16 + h0);
                    f32x4 v0 = acc[ai][bj][m][0], v1 = acc[ai][bj][m][1];
                    v0[0] += d0[0] * __builtin_bit_cast(float, uw.x << 16); v0[1] += d0[1] * __builtin_bit_cast(float, uw.x & 0xffff0000u);
                    v0[2] += d0[2] * __builtin_bit_cast(float, uw.y << 16); v0[3] += d0[3] * __builtin_bit_cast(float, uw.y & 0xffff0000u);
                    v1[0] += d1[0] * __builtin_bit_cast(float, uw.z << 16); v1[1] += d1[1] * __builtin_bit_cast(float, uw.z & 0xffff0000u);
                    v1[2] += d1[2] * __builtin_bit_cast(float, uw.w << 16); v1[3] += d1[3] * __builtin_bit_cast(float, uw.w & 0xffff0000u);
                    u32x4 w; w.x = cvt_pk_bf16(gelu_tanh_(v0[0]), gelu_tanh_(v0[1])); w.y = cvt_pk_bf16(gelu_tanh_(v0[2]), gelu_tanh_(v0[3]));
                    w.z = cvt_pk_bf16(gelu_tanh_(v1[0]), gelu_tanh_(v1[1])); w.w = cvt_pk_bf16(gelu_tanh_(v1[2]), gelu_tanh_(v1[3]));
                    *(u32x4*)(YG + (size_t)(n * 32 + t) * 512 + g * 16 + h0) = w; } }
    }
};

__device__ __forceinline__ float sigm_(float x) { return __builtin_amdgcn_rcpf(1.0f + __builtin_amdgcn_exp2f(-1.4426950408889634f * x)); }
__device__ __forceinline__ float bflo_(unsigned w) { return __builtin_bit_cast(float, w << 16); }
__device__ __forceinline__ float bfhi_(unsigned w) { return __builtin_bit_cast(float, w & 0xffff0000u); }
#define PG8_UNPACK8(dst0, dst1, WW) do { dst0[0] = bflo_(WW[0]); dst0[1] = bfhi_(WW[0]); dst0[2] = bflo_(WW[1]); dst0[3] = bfhi_(WW[1]); dst1[0] = bflo_(WW[2]); dst1[1] = bfhi_(WW[2]); dst1[2] = bflo_(WW[3]); dst1[3] = bfhi_(WW[3]); } while (0)
#define PG8_PACK8(WW, V0, V1) do { WW[0] = cvt_pk_bf16(V0[0], V0[1]); WW[1] = cvt_pk_bf16(V0[2], V0[3]); WW[2] = cvt_pk_bf16(V1[0], V1[1]); WW[3] = cvt_pk_bf16(V1[2], V1[3]); } while (0)
template <int MODE> struct EpiF {
    static constexpr bool PERM = true, AFTER_DRAIN = false;
    bf16_t* O; int ldc; const float* bias; const bf16_t* X; int ldx; const bf16_t* T;
    __device__ __forceinline__ void operator()(const f32x4 (&acc)[2][2][4][2], const Unit& u, int wr, int wc, int fr, int fq) const {
        const int row0 = u.pm * BM + wr * 64 + fr; const int col0 = u.pn * BM + wc * 32 + 8 * fq;
        f32x4 bv[2][2];
#pragma unroll
        for (int bj = 0; bj < 2; ++bj)
#pragma unroll
            for (int n = 0; n < 2; ++n) bv[bj][n] = (MODE == 1) ? *(const f32x4*)(bias + col0 + bj * HALF + 4 * n) : (f32x4){0.f, 0.f, 0.f, 0.f};
#pragma unroll
        for (int ai = 0; ai < 2; ++ai)
#pragma unroll
            for (int m = 0; m < 4; ++m) { const size_t row = (size_t)(row0 + ai * HALF + m * 16);
#pragma unroll
                for (int bj = 0; bj < 2; ++bj) { const int col = col0 + bj * HALF;
                    f32x4 v0 = acc[ai][bj][m][0] + bv[bj][0], v1 = acc[ai][bj][m][1] + bv[bj][1];
                    const u32x4 xw = *(const u32x4*)(X + row * ldx + col); f32x4 x0, x1; PG8_UNPACK8(x0, x1, xw);
                    if (MODE == 1) {
#pragma unroll
                        for (int e = 0; e < 4; ++e) { v0[e] = x0[e] * sigm_(v0[e]); v1[e] = x1[e] * sigm_(v1[e]); }
                    } else {
#pragma unroll
                        for (int e = 0; e < 4; ++e) { v0[e] = x0[e] * v0[e]; v1[e] = x1[e] * v1[e]; }
                        if (MODE == 3) { const u32x4 tw = *(const u32x4*)(T + row * ldc + col); f32x4 t0, t1; PG8_UNPACK8(t0, t1, tw); v0 += t0; v1 += t1; }
                    }
                    u32x4 w; PG8_PACK8(w, v0, v1); *(u32x4*)(O + row * ldc + col) = w; } }
    }
};
struct EpiX1 {
    static constexpr bool PERM = true, AFTER_DRAIN = false;
    const float* x; bf16_t* MIX; bf16_t* XG; const float* g1; const float* gm; float* rowss;
    int ldm;
    __device__ __forceinline__ void operator()(const f32x4 (&acc)[2][2][4][2], const Unit& u, int wr, int wc, int fr, int fq) const {
        const int row0 = u.pm * BM + wr * 64 + fr; const int col0 = u.pn * BM + wc * 32 + 8 * fq; const int b = u.pm >> 3;
        f32x4 gv[2][2], mv[2][2];
#pragma unroll
        for (int bj = 0; bj < 2; ++bj)
#pragma unroll
            for (int n = 0; n < 2; ++n) { gv[bj][n] = *(const f32x4*)(g1 + (size_t)b * ldm + col0 + bj * HALF + 4 * n); mv[bj][n] = *(const f32x4*)(gm + (size_t)b * 1024 + col0 + bj * HALF + 4 * n); }
#pragma unroll
        for (int ai = 0; ai < 2; ++ai)
#pragma unroll
            for (int m = 0; m < 4; ++m) { const size_t row = (size_t)(row0 + ai * HALF + m * 16); float ss = 0.f;
#pragma unroll
                for (int bj = 0; bj < 2; ++bj) { const size_t off = row * 1024 + col0 + bj * HALF;
                    const f32x4 xa = *(const f32x4*)(x + off), xb = *(const f32x4*)(x + off + 4);
                    const f32x4 d0 = gv[bj][0] * acc[ai][bj][m][0], d1 = gv[bj][1] * acc[ai][bj][m][1]; const f32x4 r0 = xa + d0, r1 = xb + d1;
                    { u32x4 wd; PG8_PACK8(wd, d0, d1); *(u32x4*)(MIX + off) = wd; }
                    ss += (r0[0] * r0[0] + r0[1] * r0[1]) + (r0[2] * r0[2] + r0[3] * r0[3]) + (r1[0] * r1[0] + r1[1] * r1[1]) + (r1[2] * r1[2] + r1[3] * r1[3]);
                    const f32x4 h0 = r0 * mv[bj][0], h1 = r1 * mv[bj][1]; u32x4 w; PG8_PACK8(w, h0, h1); *(u32x4*)(XG + off) = w; }
                ss += __shfl_xor(ss, 16); ss += __shfl_xor(ss, 32);
                if (fq == 0) atomicAdd(rowss + row, ss); }
    }
};
struct EpiMlp1 {
    static constexpr bool PERM = true, AFTER_DRAIN = false;
    bf16_t* O; const float* rowss; const float* shb;
    __device__ __forceinline__ void operator()(const f32x4 (&acc)[2][2][4][2], const Unit& u, int wr, int wc, int fr, int fq) const {
        const int row0 = u.pm * BM + wr * 64 + fr; const int col0 = u.pn * BM + wc * 32 + 8 * fq; const int b = u.pm >> 3;
        f32x4 bv[2][2];
#pragma unroll
        for (int bj = 0; bj < 2; ++bj)
#pragma unroll
            for (int n = 0; n < 2; ++n) bv[bj][n] = *(const f32x4*)(shb + (size_t)b * 4096 + col0 + bj * HALF + 4 * n);
#pragma unroll
        for (int ai = 0; ai < 2; ++ai)
#pragma unroll
            for (int m = 0; m < 4; ++m) { const size_t row = (size_t)(row0 + ai * HALF + m * 16);
                const float rstd = 1.0f / sqrtf(rowss[row] * (1.0f / 1024.0f) + 1e-6f);
#pragma unroll
                for (int bj = 0; bj < 2; ++bj) { f32x4 v0 = acc[ai][bj][m][0] * rstd + bv[bj][0], v1 = acc[ai][bj][m][1] * rstd + bv[bj][1];
#pragma unroll
                    for (int e = 0; e < 4; ++e) { const float a = fmaxf(v0[e], 0.f), c = fmaxf(v1[e], 0.f); v0[e] = a * a; v1[e] = c * c; }
                    u32x4 w; PG8_PACK8(w, v0, v1); *(u32x4*)(O + row * 4096 + col0 + bj * HALF) = w; } }
    }
};
struct EpiOut {
    static constexpr bool PERM = true, AFTER_DRAIN = false;
    const float* x; const bf16_t* MIX; float* out; const float* g2; const float* b2; int ldm;
    __device__ __forceinline__ void operator()(const f32x4 (&acc)[2][2][4][2], const Unit& u, int wr, int wc, int fr, int fq) const {
        const int row0 = u.pm * BM + wr * 64 + fr; const int col0 = u.pn * BM + wc * 32 + 8 * fq; const int b = u.pm >> 3;
        f32x4 gv[2][2], bv[2][2];
#pragma unroll
        for (int bj = 0; bj < 2; ++bj)
#pragma unroll
            for (int n = 0; n < 2; ++n) { gv[bj][n] = *(const f32x4*)(g2 + (size_t)b * ldm + col0 + bj * HALF + 4 * n); bv[bj][n] = *(const f32x4*)(b2 + col0 + bj * HALF + 4 * n); }
#pragma unroll
        for (int ai = 0; ai < 2; ++ai)
#pragma unroll
            for (int m = 0; m < 4; ++m) { const size_t row = (size_t)(row0 + ai * HALF + m * 16);
#pragma unroll
                for (int bj = 0; bj < 2; ++bj) { const size_t off = row * 1024 + col0 + bj * HALF; float* p = out + off;
                    const u32x4 mw = *(const u32x4*)(MIX + off); f32x4 m0, m1; PG8_UNPACK8(m0, m1, mw);
                    const f32x4 xa = *(const f32x4*)(x + off) + m0, xb = *(const f32x4*)(x + off + 4) + m1;
                    *(f32x4*)p = xa + gv[bj][0] * (acc[ai][bj][m][0] + bv[bj][0]); *(f32x4*)(p + 4) = xb + gv[bj][1] * (acc[ai][bj][m][1] + bv[bj][1]); }
                asm volatile("" ::: "memory"); }
    }
};

template <size_t OQ, size_t OKC, size_t OVC, size_t OUH, size_t OSGA, size_t OSGS, size_t ORC, size_t ORS> struct EpiIn {
    static constexpr bool PERM = true, AFTER_DRAIN = false;
    unsigned char* wsb; const float *gq, *gk;
    __device__ __forceinline__ void operator()(const f32x4 (&acc)[2][2][4][2], const Unit& u, int wr, int wc, int fr, int fq) const {
        bf16_t* const Q = (bf16_t*)(wsb + OQ); bf16_t* const KC = (bf16_t*)(wsb + OKC); bf16_t* const VC = (bf16_t*)(wsb + OVC); bf16_t* const UH = (bf16_t*)(wsb + OUH); bf16_t* const SGA = (bf16_t*)(wsb + OSGA); bf16_t* const SGS = (bf16_t*)(wsb + OSGS);
        const float* const RC = (const float*)(wsb + ORC); const float* const RS = (const float*)(wsb + ORS);
        const int pn = u.pn; const bool lat = u.pm < 128;
        const int rowt = u.pm * BM + wr * 64 + fr;
        if (pn < 5) {
            const bool isq = pn < 4; const float* gn = isq ? gq : gk;
            f32x4 gg[2][2];
#pragma unroll
            for (int bj = 0; bj < 2; ++bj)
#pragma unroll
                for (int n = 0; n < 2; ++n) gg[bj][n] = *(const f32x4*)(gn + 32 * bj + 16 * n + 4 * fq);
#pragma unroll
            for (int ai = 0; ai < 2; ++ai)
#pragma unroll
                for (int m = 0; m < 4; ++m) { const int row = rowt + ai * HALF + m * 16;
                    float ss = 0.f;
#pragma unroll
                    for (int bj = 0; bj < 2; ++bj)
#pragma unroll
                        for (int n = 0; n < 2; ++n) { const f32x4 v = acc[ai][bj][m][n]; ss += (v[0] * v[0] + v[1] * v[1]) + (v[2] * v[2] + v[3] * v[3]); }
                    ss += __shfl_xor(ss, 16); ss += __shfl_xor(ss, 32);
                    const float r = (isq ? 0.18033688011112042f : 1.0f) / sqrtf(ss * (1.0f / 64.0f) + 1e-6f);
                    const int t = row & 2047;
                    bf16_t* dst;
                    if (isq) dst = Q + (size_t)row * 1024 + pn * 256 + wc * 64 + 8 * fq;
                    else { const int rc = row - 32768; const size_t krow = lat ? (size_t)(row >> 11) * 2304 + t : (size_t)(rc >> 8) * 2304 + 2048 + (rc & 255); dst = KC + krow * 256 + wc * 64 + 8 * fq; }
#pragma unroll
                    for (int bj = 0; bj < 2; ++bj) { f32x4 x1 = acc[ai][bj][m][0] * r * gg[bj][0], x2 = acc[ai][bj][m][1] * r * gg[bj][1];
                        if (lat) { const int pos = bj == 0 ? (t >> 6) : (t & 63); const f32x4 c4 = *(const f32x4*)(RC + pos * 16 + 4 * fq), s4 = *(const f32x4*)(RS + pos * 16 + 4 * fq);
                            const f32x4 o1 = x1 * c4 - x2 * s4, o2 = x2 * c4 + x1 * s4; x1 = o1; x2 = o2; }
                        u32x4 w; PG8_PACK8(w, x1, x2); *(u32x4*)(dst + 32 * bj) = w; }
                    asm volatile("" ::: "memory"); }
        } else if (pn == 5) {
#pragma unroll
            for (int ai = 0; ai < 2; ++ai)
#pragma unroll
                for (int m = 0; m < 4; ++m) { const int row = rowt + ai * HALF + m * 16; const int rc = row - 32768;
                    const size_t krow = lat ? (size_t)(row >> 11) * 2304 + (row & 2047) : (size_t)(rc >> 8) * 2304 + 2048 + (rc & 255);
#pragma unroll
                    for (int bj = 0; bj < 2; ++bj) { u32x4 w; PG8_PACK8(w, acc[ai][bj][m][0], acc[ai][bj][m][1]); *(u32x4*)(VC + krow * 256 + bj * HALF + wc * 32 + 8 * fq) = w; } }
        } else if (pn < 8) {
#pragma unroll
            for (int ai = 0; ai < 2; ++ai)
#pragma unroll
                for (int m = 0; m < 4; ++m) { const int row = rowt + ai * HALF + m * 16; const int mc = lat ? row : row - 32768; const int nidx = (lat ? 0 : 1024) + (mc >> 5), sidx = mc & 31;
#pragma unroll
                    for (int bj = 0; bj < 2; ++bj) { const int ch0 = 256 * (pn - 6) + bj * HALF + wc * 32 + 8 * fq;
                        u32x4 w; PG8_PACK8(w, acc[ai][bj][m][0], acc[ai][bj][m][1]); *(u32x4*)(UH + ((size_t)((ch0 >> 4) * 1280 + nidx)) * 768 + sidx * 16 + (ch0 & 15)) = w; } }
        } else {
            bf16_t* G_ = (pn < 12) ? SGA : SGS;
#pragma unroll
            for (int ai = 0; ai < 2; ++ai)
#pragma unroll
                for (int m = 0; m < 4; ++m) { const int row = rowt + ai * HALF + m * 16;
#pragma unroll
                    for (int bj = 0; bj < 2; ++bj) { f32x4 v0 = acc[ai][bj][m][0], v1 = acc[ai][bj][m][1];
#pragma unroll
                        for (int e = 0; e < 4; ++e) { v0[e] = sigm_(v0[e]); v1[e] = sigm_(v1[e]); }
                        u32x4 w; PG8_PACK8(w, v0, v1); *(u32x4*)(G_ + (size_t)row * 1024 + (pn & 3) * 256 + bj * HALF + wc * 32 + 8 * fq) = w; } }
        }
    }
};

struct EpiMerge {
    static constexpr bool PERM = true, AFTER_DRAIN = false;
    bf16_t* O; const bf16_t* SGA; const bf16_t* SGS;
    __device__ __forceinline__ void mid(f32x4 (&acc)[2][2][4][2], const Unit& u, int wr, int wc, int fr, int fq) const {
        int row0 = u.pm * BM + wr * 64 + fr; int col0 = u.pn * BM + wc * 32 + 8 * fq;
        asm volatile("" : "+v"(row0), "+v"(col0));
#pragma unroll
        for (int ai = 0; ai < 2; ++ai)
#pragma unroll
            for (int m = 0; m < 4; ++m) { const size_t row = (size_t)(row0 + ai * HALF + m * 16);
#pragma unroll
                for (int bj = 0; bj < 2; ++bj) { const size_t off = row * 1024 + col0 + bj * HALF;
                    const u32x4 aw = *(const u32x4*)(SGA + off), sw = *(const u32x4*)(SGS + off); f32x4 a0, a1, s0, s1; PG8_UNPACK8(a0, a1, aw); PG8_UNPACK8(s0, s1, sw);
#pragma unroll
                    for (int e = 0; e < 4; ++e) { acc[ai][bj][m][0][e] *= s0[e] * __builtin_amdgcn_rcpf(fmaxf(a0[e], 1e-30f)); acc[ai][bj][m][1][e] *= s1[e] * __builtin_amdgcn_rcpf(fmaxf(a1[e], 1e-30f)); } }
                asm volatile("" : "+v"(acc[ai][0][m][0]), "+v"(acc[ai][0][m][1]), "+v"(acc[ai][1][m][0]), "+v"(acc[ai][1][m][1]) :: "memory"); }
    }
    __device__ __forceinline__ void operator()(const f32x4 (&acc)[2][2][4][2], const Unit& u, int wr, int wc, int fr, int fq) const {
        const int row0 = u.pm * BM + wr * 64 + fr; const int col0 = u.pn * BM + wc * 32 + 8 * fq;
#pragma unroll
        for (int ai = 0; ai < 2; ++ai)
#pragma unroll
            for (int m = 0; m < 4; ++m) { const size_t row = (size_t)(row0 + ai * HALF + m * 16);
#pragma unroll
                for (int bj = 0; bj < 2; ++bj) { const size_t off = row * 1024 + col0 + bj * HALF;
                    const u32x4 aw = *(const u32x4*)(SGA + off); f32x4 a0, a1; PG8_UNPACK8(a0, a1, aw);
                    const f32x4 v0 = acc[ai][bj][m][0] * a0, v1 = acc[ai][bj][m][1] * a1;
                    u32x4 w; PG8_PACK8(w, v0, v1); *(u32x4*)(O + off) = w; } }
    }
};
}

constexpr int NB = 16, SEQ = 2048, DM = 1024, NCTX = 256;
constexpr int MLAT = NB * SEQ, MCTX = NB * NCTX, MALL = MLAT + MCTX;
constexpr int WIN = 4096, NH = 16, NKV = 4, HD = 64, DSSM = 512, NG = 32, SGRP = 16, PST = 64, DFF = 4096;
constexpr int OFF_Q = 0, OFF_K = 1024, OFF_V = 1280, OFF_U = 1536, OFF_GA = 2048, OFF_GS = 3072;
constexpr int LTOT = NCTX + SEQ;
constexpr float NORM_EPS = 1e-6f;

constexpr size_t MiB = 1u << 20;
constexpr size_t WS_CTL = 0, CTL_ZERO_BYTES = 64 * 1024;
constexpr size_t WS_MV = 128 * 1024;
constexpr size_t WS_ROPEC = 1 * MiB + 432 * 1024, WS_ROPES = 1 * MiB + 436 * 1024;
constexpr size_t WS_KCG = 2 * MiB;
constexpr size_t WS_WIN = 4 * MiB, WS_W1 = 12 * MiB, WS_W2 = 20 * MiB, WS_BCAT = 28 * MiB  , WS_WOUT = 32 * MiB, WS_WGLU = 34 * MiB;
constexpr size_t WS_H = 36 * MiB;
constexpr size_t WS_P = 108 * MiB;
constexpr size_t WS_Q = 108 * MiB;
constexpr size_t WS_KC = 172 * MiB, WS_VC = 190 * MiB;
constexpr size_t WS_SGA = 208 * MiB, WS_SGS = 272 * MiB;
constexpr size_t WS_UH = 336 * MiB;
constexpr size_t WS_YG = 396 * MiB;
constexpr size_t WS_X1 = 364 * MiB;
constexpr size_t WS_BTC = 460 * MiB;
constexpr size_t WS_BTA = 484 * MiB;
constexpr size_t WS_END = 492 * MiB;
constexpr size_t WS_S = 36 * MiB;
constexpr size_t WS_MG = 36 * MiB;
constexpr int ACAT_LD = 1536;
constexpr int TC = 32, NROW_G = 1280;
constexpr int CW_BAR = 4096;
constexpr int CW_CNT = 8192;
constexpr size_t WS_ROWSS = 640 * 1024;
constexpr size_t WS_SHB = 768 * 1024;
constexpr size_t WS_GM = 1 * MiB;

#define GAS __attribute__((address_space(1)))
#define LAS __attribute__((address_space(3)))
typedef unsigned short bf16;
typedef unsigned v4u __attribute__((ext_vector_type(4)));
typedef unsigned v2u __attribute__((ext_vector_type(2)));
typedef float f32x4 __attribute__((ext_vector_type(4)));
typedef float f32x2 __attribute__((ext_vector_type(2)));
#define DEV __device__ __forceinline__
#define LDS_WAIT() asm volatile("s_waitcnt lgkmcnt(0)" ::: "memory")
DEV unsigned f2bf(float f) { unsigned u = __builtin_bit_cast(unsigned, f); return (u + 0x7fffu + ((u >> 16) & 1u)) >> 16; }
DEV unsigned pk2(float lo, float hi) { return f2bf(lo) | (f2bf(hi) << 16); }
DEV float bf2f(unsigned b) { return __builtin_bit_cast(float, b << 16); }
DEV float bflo(unsigned w) { return __builtin_bit_cast(float, w << 16); }
DEV float bfhi(unsigned w) { return __builtin_bit_cast(float, w & 0xffff0000u); }
DEV float wave_sum(float v) {
#pragma unroll
    for (int o = 1; o < 64; o <<= 1) v += __shfl_xor(v, o);
    return v;
}
DEV float sigmoidf_(float x) { return 1.0f / (1.0f + expf(-x)); }
DEV float gelu_tanh(float x) { const float u = 0.7978845608028654f * (x + 0.044715f * x * x * x); return 0.5f * x * (1.0f + tanhf(u)); }


DEV void cnt_arrive(unsigned* cnt) {
    asm volatile("s_waitcnt vmcnt(0)" ::: "memory");
    __syncthreads();
    if (threadIdx.x == 0) { __builtin_amdgcn_fence(__ATOMIC_RELEASE, "agent"); asm volatile("s_waitcnt vmcnt(0)" ::: "memory"); __hip_atomic_fetch_add(cnt, 1u, __ATOMIC_RELAXED, __HIP_MEMORY_SCOPE_AGENT); }
}
DEV void cnt_wait(unsigned* cnt, unsigned target, unsigned* tmo) {
    if (threadIdx.x == 0) {
        unsigned sp = 0;
        while (__hip_atomic_load(cnt, __ATOMIC_RELAXED, __HIP_MEMORY_SCOPE_AGENT) < target) { __builtin_amdgcn_s_sleep(2); if (++sp > (1u << 22)) { atomicAdd(tmo, 1u); break; } }
        __builtin_amdgcn_fence(__ATOMIC_ACQUIRE, "agent"); asm volatile("s_waitcnt vmcnt(0)" ::: "memory");
    }
    __syncthreads();
}

struct Args { const float* in[28]; float* out; unsigned char* ws; int ph_lo, ph_hi, li, pad; };

template <bool QKPERM> DEV void transpose_item(const float* W, int K, int N, bf16* WT, LAS float* scr, int item, int lane, int ldt = 0) {
    if (ldt == 0) ldt = K;
    const int nblk = N / 32, kb = item / nblk, nb = item % nblk, k0 = 64 * kb, n0 = 32 * nb;
    float wv[32];
#pragma unroll
    for (int i = 0; i < 32; ++i) { const int kk = 2 * i + (lane >> 5); wv[i] = W[(size_t)(k0 + kk) * N + n0 + (lane & 31)]; }
#pragma unroll
    for (int i = 0; i < 32; ++i) { const int kk = 2 * i + (lane >> 5); scr[kk * 33 + (lane & 31)] = wv[i]; }
    LDS_WAIT(); asm volatile("" ::: "memory");
    const int c = lane & 7;
#pragma unroll
    for (int j = 0; j < 4; ++j) { const int n = (lane >> 3) + 8 * j; const LAS float* s = scr + (8 * c) * 33 + n;
        v4u o; o.x = pk2(s[0 * 33], s[1 * 33]); o.y = pk2(s[2 * 33], s[3 * 33]); o.z = pk2(s[4 * 33], s[5 * 33]); o.w = pk2(s[6 * 33], s[7 * 33]);
        int nr = n0 + n; if (QKPERM && nr < 1280) { const int cl = nr & 255; nr = (nr & ~255) + 128 * ((cl >> 5) & 1) + 32 * (cl >> 6) + 8 * ((cl >> 2) & 3) + 4 * ((cl >> 4) & 1) + (cl & 3); }
        *(v4u*)(WT + (size_t)nr * ldt + k0 + 8 * c) = o; }
    LDS_WAIT(); asm volatile("" ::: "memory");
}

typedef float f32x16m __attribute__((ext_vector_type(16)));
DEV void ph_modvec(const Args& a, LAS unsigned char* lds, int tid, int lane, int wave, int bid, int G) {
    const float* c = a.in[1]; const float* cc = a.in[3]; const float* wm = a.in[4]; const float* bm = a.in[5];
    float* MV = (float*)(a.ws + WS_MV);
    LAS float* SC = (LAS float*)lds;
    LAS float* PR = (LAS float*)(lds + 71680);
    const int li = lane & 31, lk = lane >> 5;
    for (int slab = bid; slab < 256; slab += G) {
        float bv[64];
        { const float* wp = wm + (size_t)(128 * wave + lk) * 6144 + slab * 24 + (li < 24 ? li : 0);
#pragma unroll
          for (int t = 0; t < 64; ++t) bv[t] = wp[(size_t)(2 * t) * 6144]; }
        if (slab == bid) { for (int e = tid; e < 17 * 1024; e += 512) { const float cv = (e < 16 * 1024) ? c[e] : cc[e - 16 * 1024]; SC[(e >> 10) * 1025 + (e & 1023)] = cv / (1.0f + expf(-cv)); } }
        __syncthreads();
        f32x16m acc = {0.f, 0.f, 0.f, 0.f, 0.f, 0.f, 0.f, 0.f, 0.f, 0.f, 0.f, 0.f, 0.f, 0.f, 0.f, 0.f};
        const LAS float* sp = SC + (li < 17 ? li : 0) * 1025 + 128 * wave + lk;
#pragma unroll
        for (int t = 0; t < 64; ++t) { const float av = (li < 17) ? sp[2 * t] : 0.f; const float bw = (li < 24) ? bv[t] : 0.f; acc = __builtin_amdgcn_mfma_f32_32x32x2f32(av, bw, acc, 0, 0, 0); }
#pragma unroll
        for (int r = 0; r < 16; ++r) { const int row = (r & 3) + 8 * (r >> 2) + 4 * lk; if (row < 17 && li < 24) PR[(wave * 17 + row) * 24 + li] = acc[r]; }
        __syncthreads();
        if (tid < 408) { float sum = bm[slab * 24 + (tid % 24)];
#pragma unroll
            for (int w = 0; w < 8; ++w) sum += PR[w * 408 + tid];
            MV[(tid / 24) * 6144 + slab * 24 + (tid % 24)] = sum; }
        __syncthreads();
    }
}

DEV void ph_prologue(const Args& a, LAS unsigned char* lds, int tid, int lane, int wave, int bid, int G) {
    unsigned char* ws = a.ws;
    LAS float* scr = (LAS float*)(lds + wave * 16384);
    const int gw = bid * 8 + wave, NGW = G * 8;
    for (int it = gw; it < 16 * 128; it += NGW) transpose_item<true>(a.in[8], 1024, 4096, (bf16*)(ws + WS_WIN), scr, it, lane);
    {
        const int gt = bid * 512 + tid;
        for (int e = gt; e < (128 + 256) * 1024 / 16; e += G * 512) ((f32x4*)(ws + WS_ROWSS))[e] = (f32x4){0.f, 0.f, 0.f, 0.f};
        if (gt < 1024) {
            const int pos = gt >> 4, j = gt & 15;
            const float invf = powf(10000.0f, -(float)j / 16.0f);
            const float ang = (float)pos * invf;
            ((float*)(ws + WS_ROPEC))[gt] = cosf(ang); ((float*)(ws + WS_ROPES))[gt] = sinf(ang);
        }
    }
}

DEV void ph_transposes_rest(const Args& a, LAS unsigned char* lds, int lane, int wave, int gw, int NGW) {
    unsigned char* ws = a.ws; LAS float* scr = (LAS float*)(lds + wave * 16384);
    constexpr int I_1 = 16 * 128, I_2 = 64 * 32, I_A = 16 * 32, I_O = 16 * 32, I_S = 8 * 32, I_G = 8 * 16;
    constexpr int NITEMS = I_1 + I_2 + I_A + I_O + I_S + I_G;
    for (int it = gw; it < NITEMS; it += NGW) {
        int r = it;
        if (r < I_1) { transpose_item<false>(a.in[24], 1024, 4096, (bf16*)(ws + WS_W1), scr, r, lane); continue; } r -= I_1;
        if (r < I_2) { transpose_item<false>(a.in[26], 4096, 1024, (bf16*)(ws + WS_W2), scr, r, lane); continue; } r -= I_2;
        if (r < I_A) { transpose_item<false>(a.in[21], 1024, 1024, (bf16*)(ws + WS_BCAT) + 512, scr, r, lane, 1536); continue; } r -= I_A;
        if (r < I_O) { transpose_item<false>(a.in[23], 1024, 1024, (bf16*)(ws + WS_WOUT), scr, r, lane); continue; } r -= I_O;
        if (r < I_S) { transpose_item<false>(a.in[22], 512, 1024, (bf16*)(ws + WS_BCAT), scr, r, lane, 1536); continue; } r -= I_S;
        transpose_item<false>(a.in[19], 512, 512, (bf16*)(ws + WS_WGLU), scr, r, lane);
    }
}

DEV void ph_normmod(const Args& a, int lane, int wave, int bid, int G) {
    const int gw = bid * 8 + wave, NGW = G * 8;
    const float* MV = (const float*)(a.ws + WS_MV); const float* gn = a.in[6]; bf16* H = (bf16*)(a.ws + WS_H);
    const int rpw = (MALL + NGW - 1) / NGW;
    const int m0 = gw * rpw, m1 = (m0 + rpw < MALL) ? m0 + rpw : MALL;
    f32x4 nx[3][4];
#define NM_LOAD(slot, m_) do { const int mm_ = (m_); if (mm_ < m1) { const float* xr_ = (mm_ < MLAT) ? a.in[0] + (size_t)mm_ * DM : a.in[2] + (size_t)(mm_ - MLAT) * DM; \
        _Pragma("unroll") for (int j = 0; j < 4; ++j) nx[slot][j] = ((const f32x4*)xr_)[lane + 64 * j]; } } while (0)
#define NM_ROW(slot, m_) do { const int mr_ = (m_); if (mr_ < m1) { const float* mv = MV + ((mr_ < MLAT) ? (mr_ / SEQ) : 16) * 6144; \
        f32x4 v[4]; float ss = 0.f; \
        _Pragma("unroll") for (int j = 0; j < 4; ++j) { v[j] = nx[slot][j]; ss += (v[j].x * v[j].x + v[j].y * v[j].y) + (v[j].z * v[j].z + v[j].w * v[j].w); } \
        NM_LOAD(slot, mr_ + 3); \
        const float rstd = 1.0f / sqrtf(wave_sum(ss) * (1.0f / DM) + NORM_EPS); \
        _Pragma("unroll") for (int j = 0; j < 4; ++j) { const int k4 = lane + 64 * j; \
            const f32x4 g4 = ((const f32x4*)gn)[k4], sh = ((const f32x4*)mv)[k4], sc = ((const f32x4*)(mv + 1024))[k4]; \
            const f32x4 h = v[j] * rstd * g4 * (sc + 1.0f) + sh; \
            v2u o; o.x = pk2(h.x, h.y); o.y = pk2(h.z, h.w); ((v2u*)(H + (size_t)mr_ * DM))[k4] = o; } } } while (0)
    NM_LOAD(0, m0); NM_LOAD(1, m0 + 1); NM_LOAD(2, m0 + 2);
    for (int m = m0; m < m1; m += 3) { NM_ROW(0, m); NM_ROW(1, m + 1); NM_ROW(2, m + 2); }
#undef NM_LOAD
#undef NM_ROW
}

DEV void ph_mlp_consts(const Args& a, LAS unsigned char* lds, int tid, int lane, int wave, int bid, int G) {
    const float* MV = (const float*)(a.ws + WS_MV); float* GM = (float*)(a.ws + WS_GM); float* SHB = (float*)(a.ws + WS_SHB);
    for (int e = bid * 512 + tid; e < 16 * 1024; e += G * 512) { const int b = e >> 10, k = e & 1023; GM[e] = a.in[7][k] * (1.0f + MV[b * 6144 + 4096 + k]); }
    LAS float* scr = (LAS float*)(lds + wave * 16384);
    const int gw = bid * 8 + wave, NGW = G * 8; const float* w1 = a.in[24]; const float* b1 = a.in[25];
    for (int it = NGW - 1 - gw; it < 64 * 32; it += NGW) {
        const int cb = it & 63, ks = it >> 6, col = cb * 64 + lane, k0 = ks * 32;
        float w[32];
#pragma unroll
        for (int j = 0; j < 32; ++j) w[j] = w1[(size_t)(k0 + j) * 4096 + col];
        for (int i = lane; i < 16 * 32; i += 64) { const int b = i >> 5, kk = i & 31; scr[i] = MV[b * 6144 + 3072 + k0 + kk]; }
        LDS_WAIT(); asm volatile("" ::: "memory");
        const float bb = (ks == 0) ? b1[col] : 0.f;
#pragma unroll
        for (int b = 0; b < 16; ++b) { float acc = bb;
#pragma unroll
            for (int j4 = 0; j4 < 8; ++j4) { const f32x4 s4 = *(const LAS f32x4*)(scr + b * 32 + 4 * j4); acc += (s4.x * w[4 * j4] + s4.y * w[4 * j4 + 1]) + (s4.z * w[4 * j4 + 2] + s4.w * w[4 * j4 + 3]); }
            atomicAdd(SHB + b * 4096 + col, acc); }
        LDS_WAIT(); asm volatile("" ::: "memory");
    }
}

DEV void ph_attn(const Args& a, char* lds_generic, int bid, int G, int r0, int r1) {
    const attn_body::bf16* Q = (const attn_body::bf16*)(a.ws + WS_Q); const attn_body::bf16* KC = (const attn_body::bf16*)(a.ws + WS_KC); const attn_body::bf16* VC = (const attn_body::bf16*)(a.ws + WS_VC);
    attn_body::bf16* AO = (attn_body::bf16*)a.out + 512;
    const int vcu = (G % 8 == 0) ? (bid % 8) * (G / 8) + bid / 8 : bid;
#pragma nounroll
    for (int r = r0; r < r1; ++r) { const int L = vcu + r * G; if (L >= NB * NH * (SEQ / 256)) break;
        const int grp = L >> 5, j = L & 31; const int b = grp >> 2, kvh = grp & 3; const int h = kvh * 4 + (j >> 3), qb = j & 7;
        const attn_body::bf16* kb = KC + (size_t)b * LTOT * 256; const attn_body::bf16* vb = VC + (size_t)b * LTOT * 256;
        attn_body::attn_unit<8, DM, 256, ACAT_LD>(h, qb, Q + (size_t)b * SEQ * DM, kb, vb, kb + (size_t)SEQ * 256, vb + (size_t)SEQ * 256, AO + (size_t)b * SEQ * ACAT_LD, lds_generic);
    }
}

DEV void ssm_disc(const Args& a, int idx, f32x2& av, f32x2& coef) {
    const int dg = idx >> 6;
    const float dt = expf(a.in[13][dg]);
    const float lre = a.in[11][idx], lim = a.in[12][idx];
    const float zr = lre * dt, zi = lim * dt;
    const float ex = expf(zr), sn = sinf(zi), cs = cosf(zi);
    const float sh = sinf(0.5f * zi), em1 = expm1f(zr);
    const float nre = em1 * cs - 2.0f * sh * sh, nim = ex * sn;
    const float den = lre * lre + lim * lim;
    av = (f32x2){ex * cs, ex * sn}; coef = (f32x2){(nre * lre + nim * lim) / den, (nim * lre - nre * lim) / den};
}
DEV f32x2 cmul(f32x2 x, f32x2 y) { return (f32x2){x.x * y.x - x.y * y.y, x.x * y.y + x.y * y.x}; }

DEV void ssm_kc_item(const Args& a, LAS float* scr, int item, int lane) {
    const int g = item / 63, di = item % 63, dl = di - 31;
    LAS f32x2* X = (LAS f32x2*)scr;
    LAS f32x2* Cw = X + 1024;
    const int h = lane >> 2, hq = lane & 3;
    float acc0 = 0.f, acc1 = 0.f, acc2 = 0.f, acc3 = 0.f;
    for (int dir = 0; dir < 2; ++dir) {
        if ((dir == 0 && dl < 0) || (dir == 1 && dl > 0)) continue;
        const int idx = (dir * 32 + g) * 64 + lane; f32x2 av, coef; ssm_disc(a, idx, av, coef);
        int e = dl < 0 ? -dl : dl; f32x2 pw = (f32x2){1.f, 0.f}, bs = av;
        while (e) { if (e & 1) pw = cmul(pw, bs); bs = cmul(bs, bs); e >>= 1; }
        const f32x2 pc = cmul(pw, coef);
#pragma unroll
        for (int hp = 0; hp < 16; ++hp) X[lane * 16 + hp] = cmul(pc, (f32x2){a.in[14][(size_t)idx * 16 + hp], a.in[15][(size_t)idx * 16 + hp]});
#pragma unroll
        for (int hh = 0; hh < 16; ++hh) Cw[hh * 64 + lane] = (f32x2){a.in[16][(size_t)((dir * 32 + g) * 16 + hh) * 64 + lane], a.in[17][(size_t)((dir * 32 + g) * 16 + hh) * 64 + lane]};
        LDS_WAIT(); asm volatile("" ::: "memory");
        for (int p = 0; p < 64; ++p) { const f32x2 c = Cw[h * 64 + p]; const LAS f32x4* xp = (const LAS f32x4*)(X + p * 16 + 4 * hq); const f32x4 xa = xp[0], xb = xp[1];
            acc0 += c.x * xa.x - c.y * xa.y; acc1 += c.x * xa.z - c.y * xa.w; acc2 += c.x * xb.x - c.y * xb.y; acc3 += c.x * xb.z - c.y * xb.w; }
        LDS_WAIT(); asm volatile("" ::: "memory");
    }
    v2u o; o.x = pk2(acc0, acc1); o.y = pk2(acc2, acc3);
    *(v2u*)((bf16*)(a.ws + WS_KCG) + (size_t)item * 256 + h * 16 + 4 * hq) = o;
}

DEV void ssm_expand(const Args& a, LAS unsigned char* lds, int tid, int item) {
    const int g = item >> 3, q = item & 7;
    LAS f32x2* PW = (LAS f32x2*)lds;
    LAS f32x2* BBl = (LAS f32x2*)(lds + 33792);
    LAS f32x2* Cl = (LAS f32x2*)(lds + 33792 + 16384);
    __syncthreads();
    if (tid < 128) {
        const int dir = tid >> 6, p = tid & 63, idx = (dir * 32 + g) * 64 + p;
        f32x2 av, coef; ssm_disc(a, idx, av, coef);
        f32x2 w = (f32x2){1.f, 0.f};
        for (int k = 0; k <= 32; ++k) { PW[tid * 33 + k] = w; w = cmul(w, av); }
#pragma unroll
        for (int h = 0; h < 16; ++h) BBl[tid * 16 + h] = cmul(coef, (f32x2){a.in[14][(size_t)idx * 16 + h], a.in[15][(size_t)idx * 16 + h]});
    }
    for (int e = tid; e < 2048; e += 512) { const int dir = e >> 10, hp = e & 1023; Cl[e] = (f32x2){a.in[16][(size_t)(dir * 32 + g) * 1024 + hp], a.in[17][(size_t)(dir * 32 + g) * 1024 + hp]}; }
    __syncthreads();
    bf16* BtC = (bf16*)(a.ws + WS_BTC) + (size_t)g * 512 * 768; bf16* BtA = (bf16*)(a.ws + WS_BTA) + (size_t)g * 256 * 512; const bf16* KCG = (const bf16*)(a.ws + WS_KCG) + (size_t)g * 63 * 256;
#pragma unroll
    for (int i = 0; i < 8; ++i) { const int cid = tid + 512 * i, row = cid >> 6, tl = row >> 4, h = row & 15, ch = cid & 63, sidx = ch >> 1, half = ch & 1;
        const int di = 4 * q + tl - sidx + 31;
        const v4u val = *(const v4u*)(KCG + (size_t)di * 256 + h * 16 + half * 8);
        *(v4u*)(BtC + (size_t)((4 * q + tl) * 16 + h) * 768 + sidx * 16 + half * 8) = val; }
    for (int e = tid; e < 64 * 32; e += 512) { const int row = e >> 5, c4 = e & 31, tl = row >> 4, h = row & 15, t = 4 * q + tl;
        v4u o;
#pragma unroll
        for (int j = 0; j < 4; ++j) { const int pc = 4 * c4 + j, dir = pc >> 6, p = pc & 63; const int pe = dir == 0 ? t + 1 : 32 - t;
            const f32x2 cw = cmul(Cl[(dir * 16 + h) * 64 + p], PW[(dir * 64 + p) * 33 + pe]); o[j] = pk2(cw.x, -cw.y); }
        *(v4u*)(BtC + (size_t)(t * 16 + h) * 768 + 512 + 8 * c4) = o; }
    for (int e = tid; e < 32 * 64; e += 512) { const int rl = e >> 6, k8 = e & 63, r = 32 * q + rl, dir = r >> 7, p = (r >> 1) & 63, ri = r & 1, sidx = k8 >> 1, hp0 = (k8 & 1) * 8;
        const int pe = dir == 0 ? 31 - sidx : sidx; const f32x2 pw = PW[(dir * 64 + p) * 33 + pe];
        float vv[8];
#pragma unroll
        for (int j = 0; j < 8; ++j) { const f32x2 v = cmul(pw, BBl[(dir * 64 + p) * 16 + hp0 + j]); vv[j] = ri == 0 ? v.x : v.y; }
        v4u o; o.x = pk2(vv[0], vv[1]); o.y = pk2(vv[2], vv[3]); o.z = pk2(vv[4], vv[5]); o.w = pk2(vv[6], vv[7]);
        *(v4u*)(BtA + (size_t)r * 512 + sidx * 16 + hp0) = o; }
    LDS_WAIT();
}

DEV void ph_scan(const Args& a, int lane, int wave, int bid, int G) {
    const float* S = (const float*)(a.ws + WS_S); bf16* UH = (bf16*)(a.ws + WS_UH);
    for (int w = wave * G + bid; w < 1024; w += 8 * G) {
        const int dir = w & 1, g = (w >> 1) & 31, b = w >> 6;
        f32x2 av, coef; ssm_disc(a, (dir * 32 + g) * 64 + lane, av, coef);
        f32x2 a32 = av;
#pragma unroll
        for (int i = 0; i < 5; ++i) a32 = cmul(a32, a32);
        const int col = dir * 128 + 2 * lane;
        const float* Sg = S + (size_t)g * NROW_G * 256 + col; bf16* Ug = UH + (size_t)g * NROW_G * 768 + 512 + col;
        f32x2 H = (f32x2){0.f, 0.f};
        { f32x2 sv[8];
#pragma unroll
          for (int c = 0; c < 8; ++c) { const int cc = dir == 0 ? c : 7 - c; sv[c] = *(const f32x2*)(Sg + (size_t)(1024 + b * 8 + cc) * 256); }
#pragma unroll
          for (int c = 0; c < 8; ++c) { H = cmul(a32, H); H.x += sv[c].x; H.y += sv[c].y; } }
        for (int j0 = 0; j0 < 64; j0 += 8) {
            f32x2 sv[8];
#pragma unroll
            for (int c = 0; c < 8; ++c) { const int j = dir == 0 ? j0 + c : 63 - (j0 + c); sv[c] = *(const f32x2*)(Sg + (size_t)(b * 64 + j) * 256); }
#pragma unroll
            for (int c = 0; c < 8; ++c) { const int j = dir == 0 ? j0 + c : 63 - (j0 + c);
                *(unsigned*)(Ug + (size_t)(b * 64 + j) * 768) = pk2(H.x, H.y);
                H = cmul(a32, H); H.x += sv[c].x; H.y += sv[c].y; }
        }
    }
}
#define XB_TMO      128
#define XB_XCNT(j)  (256  + 64 * (j))
#define XB_XSUB(j)  (1280 + 64 * (j))
#define XB_XGEN(j)  (2304 + 64 * (j))
#define XB_TOP      3328
#define XB_TOPGEN   3392
#define XCD_BAR_WORDS 3456
#define XB_SPIN_CAP (1u << 18)

__device__ __forceinline__ unsigned xb_ld(unsigned* p)              { return __hip_atomic_load(p, __ATOMIC_RELAXED, __HIP_MEMORY_SCOPE_AGENT); }
__device__ __forceinline__ unsigned xb_add(unsigned* p, unsigned v) { return __hip_atomic_fetch_add(p, v, __ATOMIC_RELAXED, __HIP_MEMORY_SCOPE_AGENT); }
__device__ __forceinline__ unsigned xb_xcc_id() { return (unsigned)__builtin_amdgcn_s_getreg((3 << 11) | 20) & 0xFu; }
#define XB_SPIN(cond, bar) do { unsigned _sp = 0; while (cond) { __builtin_amdgcn_s_sleep(1); \
    if ((++_sp & 255u) == 0u) { if (xb_ld(&(bar)[XB_TMO])) break; if (_sp > XB_SPIN_CAP) { atomicAdd(&(bar)[XB_TMO], 1u); break; } } } } while (0)

struct XcdBarrier {
    unsigned* bar; unsigned x;
    volatile LAS unsigned* st;
};

__device__ __forceinline__ XcdBarrier xcd_barrier_post(unsigned* bar, volatile LAS unsigned* st) {
    XcdBarrier b; b.bar = bar; b.x = xb_xcc_id(); b.st = st;
    if (threadIdx.x == 0) (void)xb_add(&bar[XB_XCNT(b.x)], 1u);
    return b;
}
__device__ __forceinline__ void xcd_barrier_complete(unsigned* bar, unsigned x, unsigned& nloc, unsigned& nx) {
    const unsigned G = gridDim.x * gridDim.y * gridDim.z;
    unsigned sum, cnt, mine, sp = 0u;
    for (;;) {
        sum = 0u; cnt = 0u; mine = 0u;
#pragma unroll
        for (unsigned j = 0; j < 16; ++j) { const unsigned c = xb_ld(&bar[XB_XCNT(j)]); sum += c; cnt += (c > 0u) ? 1u : 0u; mine = (j == x) ? c : mine; }
        if (sum == G) break;
        __builtin_amdgcn_s_sleep(1);
        if ((++sp & 255u) == 0u) { if (xb_ld(&bar[XB_TMO])) break; if (sp > XB_SPIN_CAP) { atomicAdd(&bar[XB_TMO], 1u); break; } }
    }
    nloc = mine > 0u ? mine : 1u; nx = cnt > 0u ? cnt : 1u;
}

__device__ __forceinline__ void xcd_barrier(const XcdBarrier& b) {
    asm volatile("s_waitcnt vmcnt(0)" ::: "memory");
    __syncthreads();
    if (threadIdx.x == 0) {
        unsigned* bar = b.bar;
        __builtin_amdgcn_s_waitcnt(0);
        unsigned nloc = b.st[0], nx = b.st[1];
        if (nloc == 0u) { xcd_barrier_complete(bar, b.x, nloc, nx); b.st[0] = nloc; b.st[1] = nx; }
        const unsigned old = xb_add(&bar[XB_XSUB(b.x)], 1u);
        const unsigned gen = old / nloc;
        if (old + 1u == (gen + 1u) * nloc) {
            __builtin_amdgcn_fence(__ATOMIC_RELEASE, "agent");
            asm volatile("s_waitcnt vmcnt(0)" ::: "memory");
            const unsigned og = xb_add(&bar[XB_TOP], 1u);
            const unsigned tg = og / nx;
            if (og + 1u == (tg + 1u) * nx) xb_add(&bar[XB_TOPGEN], 1u);
            else XB_SPIN(xb_ld(&bar[XB_TOPGEN]) == tg, bar);
            __builtin_amdgcn_fence(__ATOMIC_ACQUIRE, "agent");
            xb_add(&bar[XB_XGEN(b.x)], 1u);
            asm volatile("s_waitcnt vmcnt(0)" ::: "memory");
        } else {
            XB_SPIN(xb_ld(&bar[XB_XGEN(b.x)]) == gen, bar);
            __builtin_amdgcn_fence(__ATOMIC_ACQUIRE, "agent");
            asm volatile("s_waitcnt vmcnt(0)" ::: "memory");
        }
    }
    __syncthreads();
}

constexpr int NPHASE = 7;
constexpr int LDS_BYTES = 147456;
constexpr int RING_BYTES = 131072, MISC_OFF = RING_BYTES + 320;


__global__ void __launch_bounds__(512, 2) mega(Args args) {
    extern __shared__ __attribute__((aligned(16))) unsigned char lds_raw[];
    LAS unsigned char* lds = (LAS unsigned char*)lds_raw;
    const int tid = threadIdx.x, lane = tid & 63, wave = __builtin_amdgcn_readfirstlane(tid >> 6);
    const int G = gridDim.x, bid = blockIdx.x;
    unsigned char* ws = args.ws;
    for (int u = tid; u < (LDS_BYTES - RING_BYTES) / 4; u += 512) ((LAS unsigned*)(lds + RING_BYTES))[u] = 0u;
    __syncthreads();
    const bool multi = (args.ph_hi - args.ph_lo) > 1;
    XcdBarrier bar; bar.bar = (unsigned*)(ws + WS_CTL) + CW_BAR; bar.x = 0; bar.st = nullptr;
    if (multi) bar = xcd_barrier_post((unsigned*)(ws + WS_CTL) + CW_BAR, (volatile LAS unsigned*)(lds + MISC_OFF) + 8);


    const int lo = args.ph_lo, hi = args.ph_hi;
#define IN(k) (lo <= (k) && (k) < hi)
#define SEAM(k) do { if (IN(k) && IN((k) + 1)) xcd_barrier(bar); } while (0)
#ifndef PH_MASK
#define PH_MASK 0x7f
#endif
#define PH_EN(k) ((PH_MASK >> (k)) & 1)
#ifndef WGM_IN
#define WGM_IN 4
#endif
#ifndef WGM_M1
#define WGM_M1 4
#endif
#ifndef DUP_MASK
#define DUP_MASK 0
#endif
#define RUN(k, ...) do { if (PH_EN(k) && IN(k)) { __VA_ARGS__; if ((DUP_MASK >> (k)) & 1) { xcd_barrier(bar); __VA_ARGS__; } } SEAM(k); } while (0)
    RUN(0, { unsigned* const cnt0 = (unsigned*)(ws + WS_CTL) + CW_CNT + 192; unsigned* const tmo0 = (unsigned*)(ws + WS_CTL) + CW_BAR + XB_TMO;
        ph_modvec(args, lds, tid, lane, wave, bid, G); cnt_arrive(cnt0);
        ph_prologue(args, lds, tid, lane, wave, bid, G); for (int it = bid * 8 + wave; it < 32 * 63; it += G * 8) ssm_kc_item(args, (LAS float*)(lds + wave * 16384), it, lane);
        cnt_wait(cnt0, (unsigned)G, tmo0); ph_normmod(args, lane, wave, bid, G); });
    RUN(1, { pg8::Gemm g{(const bf16*)(ws + WS_H), (const bf16*)(ws + WS_WIN), MLAT, WIN, DM, DM, DM}; pg8::SchedX S; S.so.init(MLAT, WIN, G, bid, WGM_IN); S.extra = (MCTX / 256) * 4; S.xpm0 = MLAT / 256; S.xpn0 = 4; S.xnn = 4;
        typedef pg8::EpiIn<WS_Q, WS_KC, WS_VC, WS_UH, WS_SGA, WS_SGS, WS_ROPEC, WS_ROPES> EpiInT; EpiInT E{ws, args.in[9], args.in[10]};
        pg8::gemm_phase<EpiInT, pg8::SchedX, true, true>(lds, g, S, E);
        if (G > 64 && bid >= 64) {
            const int sb = bid - 64, SG = G - 64;
            for (int it = sb; it < 256; it += SG) ssm_expand(args, lds, tid, it);
            __syncthreads();
            const int two = 256 - SG;
            if (two <= 0 || two >= SG) { ph_transposes_rest(args, lds, lane, wave, sb * 8 + wave, SG * 8); ph_mlp_consts(args, lds, tid, lane, wave, sb, SG); }
            else if (sb >= two) { ph_transposes_rest(args, lds, lane, wave, (sb - two) * 8 + wave, (SG - two) * 8); ph_mlp_consts(args, lds, tid, lane, wave, sb - two, SG - two); } } });
    RUN(2, {
        unsigned* const cnt = (unsigned*)(ws + WS_CTL) + CW_CNT; unsigned* const tmo = (unsigned*)(ws + WS_CTL) + CW_BAR + XB_TMO;
        { pg8::Gemm g{(const bf16*)(ws + WS_UH), (const bf16*)(ws + WS_BTA), 32 * NROW_G, 32 * 256, 512, 768, 512};
          pg8::SchedSsm S{160, G, bid, 0}; pg8::EpiS E{(float*)(ws + WS_S)};
          pg8::gemm_phase<pg8::EpiS, pg8::SchedSsm, true, true>(lds, g, S, E); }
        cnt_arrive(cnt + 0);
        ph_attn(args, (char*)lds_raw, bid, G, 0, 2);
        cnt_wait(cnt + 0, (unsigned)G, tmo); ph_scan(args, lane, wave, bid, G); cnt_arrive(cnt + 64);
        ph_attn(args, (char*)lds_raw, bid, G, 2, 4);
        cnt_wait(cnt + 64, (unsigned)G, tmo);
        { pg8::Gemm g{(const bf16*)(ws + WS_UH), (const bf16*)(ws + WS_BTC), 32 * NROW_G, 32 * 512, 768, 768, 768};
          pg8::SchedSsm S{256, G, bid, 1}; pg8::EpiY E{(bf16*)(ws + WS_YG), (const bf16*)(ws + WS_UH), args.in[18]};
          pg8::gemm_phase<pg8::EpiY, pg8::SchedSsm, true, true>(lds, g, S, E); }
        cnt_arrive(cnt + 128);
        ph_attn(args, (char*)lds_raw, bid, G, 4, 6);
        cnt_wait(cnt + 128, (unsigned)G, tmo);
        { pg8::Gemm g{(const bf16*)(ws + WS_YG), (const bf16*)(ws + WS_WGLU), MLAT, DSSM, DSSM, DSSM, DSSM};
          pg8::SchedX S; S.so.init(MLAT, DSSM, G, bid); S.extra = 0; S.xpm0 = 0; S.xpn0 = 0; S.xnn = 1;
          pg8::EpiF<1> E{(bf16*)args.out, ACAT_LD, args.in[20], (const bf16*)(ws + WS_YG), DSSM, nullptr};
          pg8::gemm_phase<pg8::EpiF<1>, pg8::SchedX, true, true>(lds, g, S, E); }
        ph_attn(args, (char*)lds_raw, bid, G, 6, 8); });
    RUN(3, { pg8::Gemm g{(const bf16*)args.out, (const bf16*)(ws + WS_BCAT), MLAT, DM, ACAT_LD, ACAT_LD, ACAT_LD};
        pg8::SchedX S; S.so.init(MLAT, DM, G, bid); S.extra = 0; S.xpm0 = 0; S.xpn0 = 0; S.xnn = 1;
        pg8::EpiMerge E{(bf16*)(ws + WS_MG), (const bf16*)(ws + WS_SGA), (const bf16*)(ws + WS_SGS)};
        pg8::gemm_phase<pg8::EpiMerge, pg8::SchedX, true, true, 8>(lds, g, S, E); });
    RUN(4, { pg8::Gemm g{(const bf16*)(ws + WS_MG), (const bf16*)(ws + WS_WOUT), MLAT, DM, DM, DM, DM};
        pg8::SchedX S; S.so.init(MLAT, DM, G, bid); S.extra = 0; S.xpm0 = 0; S.xpn0 = 0; S.xnn = 1;
        pg8::EpiX1 E{args.in[0], (bf16*)(ws + WS_X1), (bf16*)args.out, (const float*)(ws + WS_MV) + 2048, (const float*)(ws + WS_GM), (float*)(ws + WS_ROWSS), 6144};
        pg8::gemm_phase<pg8::EpiX1, pg8::SchedX, true, true>(lds, g, S, E); });
    RUN(5, { pg8::Gemm g{(const bf16*)args.out, (const bf16*)(ws + WS_W1), MLAT, DFF, DM, DM, DM};
        pg8::SchedX S; S.so.init(MLAT, DFF, G, bid, WGM_M1); S.extra = 0; S.xpm0 = 0; S.xpn0 = 0; S.xnn = 1;
        pg8::EpiMlp1 E{(bf16*)(ws + WS_P), (const float*)(ws + WS_ROWSS), (const float*)(ws + WS_SHB)};
        pg8::gemm_phase<pg8::EpiMlp1, pg8::SchedX, true, true>(lds, g, S, E); });
    RUN(6, { pg8::Gemm g{(const bf16*)(ws + WS_P), (const bf16*)(ws + WS_W2), MLAT, DM, DFF, DFF, DFF};
        pg8::SchedX S; S.so.init(MLAT, DM, G, bid); S.extra = 0; S.xpm0 = 0; S.xpn0 = 0; S.xnn = 1; S.rev = (G == 256) ? 2 : 0;
        pg8::EpiOut E{args.in[0], (const bf16*)(ws + WS_X1), args.out, (const float*)(ws + WS_MV) + 5120, args.in[27], 6144};
        pg8::gemm_phase<pg8::EpiOut, pg8::SchedX, true, true>(lds, g, S, E); });
#undef IN
#undef SEAM
}

#ifndef MK_SPLIT
#define MK_SPLIT 0
#endif
extern "C" void kernel_launch(void* const* d_in, const int* in_sizes, int n_in, void* d_out, int out_size, void* d_ws, size_t ws_size, hipStream_t stream) {
    static int grid = 0;
    if (grid == 0) {
        if (n_in != 28 || out_size != MLAT * DM || ws_size < WS_END) { fprintf(stderr, "kernel_launch: unexpected shapes (n_in %d out %d ws %zu)\n", n_in, out_size, ws_size); grid = -1; return; }
        int dev = 0, cus = 0, per_cu = 0;
        hipGetDevice(&dev); hipDeviceGetAttribute(&cus, hipDeviceAttributeMultiprocessorCount, dev);
        hipFuncSetAttribute((const void*)mega, hipFuncAttributeMaxDynamicSharedMemorySize, LDS_BYTES);
        hipOccupancyMaxActiveBlocksPerMultiprocessor(&per_cu, (const void*)mega, 512, LDS_BYTES);
        (void)hipGetLastError();
        if (per_cu < 1) { fprintf(stderr, "kernel_launch: occupancy query says %d blocks/CU\n", per_cu); per_cu = 1; }
        grid = cus;
        fprintf(stderr, "kernel_launch: grid %d (cus %d, per_cu %d)\n", grid, cus, per_cu);
    }
    if (grid < 0) return;
    hipMemsetAsync((char*)d_ws + WS_CTL, 0, CTL_ZERO_BYTES, stream);
    Args a{};
    for (int i = 0; i < 28; ++i) a.in[i] = (const float*)d_in[i];
    a.out = (float*)d_out; a.ws = (unsigned char*)d_ws;
#if MK_SPLIT
    for (int ph = 0; ph < NPHASE; ++ph) { a.ph_lo = ph; a.ph_hi = ph + 1; a.li = ph; hipLaunchKernelGGL(mega, dim3(grid), dim3(512), LDS_BYTES, stream, a); }
#else
    a.ph_lo = 0; a.ph_hi = NPHASE; a.li = 0;
    hipLaunchKernelGGL(mega, dim3(grid), dim3(512), LDS_BYTES, stream, a);
#endif
}
```
